# Optimizing an MI355X kernel written in HIP

```python
import jax, jax.numpy as jnp
from jax import lax
import numpy as np

D_MODEL = 1024
BATCH = 8
SEQ = 2048
DEPTH = 2

D_MIX = 2 * D_MODEL
CONV_W = D_MIX // 4
CONV_K = 31
RET_W = D_MIX // 4
RET_HEADS = 4
RET_HD = RET_W // RET_HEADS
RET_CHUNK = 128
MLA_W = D_MIX // 2
MLA_HEADS = 8
MLA_V_HD = MLA_W // MLA_HEADS
MLA_NOPE = 128
MLA_ROPE = 64
MLA_Q_RANK = 384
MLA_KV_RANK = 256
ATTN_BLOCK = 128
ROPE_BASE = 10000.0
EPS = 1e-6

OFF_RET = 2 * CONV_W
OFF_QLAT = OFF_RET + 3 * RET_W
OFF_KVLAT = OFF_QLAT + MLA_Q_RANK
OFF_KROPE = OFF_KVLAT + MLA_KV_RANK
OFF_GATE = OFF_KROPE + MLA_ROPE
N_IN = OFF_GATE + D_MIX
SPLIT_POINTS = (OFF_RET, OFF_QLAT, OFF_KVLAT, OFF_KROPE, OFF_GATE)

kernel_name = "hybrid_conv_retention_mla_encoder"


def rmsnorm(x, g):
    xf = x.astype(jnp.float32)
    y = xf * lax.rsqrt(jnp.mean(xf * xf, axis=-1, keepdims=True) + EPS)
    return (y * g.astype(jnp.float32)).astype(x.dtype)


def rope_tables(seq, dim, dtype):
    inv = 1.0 / (ROPE_BASE ** (jnp.arange(0, dim, 2, dtype=jnp.float32) / dim))
    ang = jnp.arange(seq, dtype=jnp.float32)[:, None] * inv[None, :]
    ang = jnp.concatenate([ang, ang], axis=-1)
    return jnp.cos(ang).astype(dtype), jnp.sin(ang).astype(dtype)


def apply_rope(x, cos, sin):
    x1, x2 = jnp.split(x, 2, axis=-1)
    return x * cos + jnp.concatenate([-x2, x1], axis=-1) * sin


def conv_module(u, dw_w, dw_b, ln_g, ln_b):
    a, b = jnp.split(u, 2, axis=-1)
    h = a * jax.nn.sigmoid(b)
    h = lax.conv_general_dilated(
        h, dw_w[:, None, :].astype(h.dtype), window_strides=(1,),
        padding=[(CONV_K // 2, CONV_K // 2)],
        dimension_numbers=('NWC', 'WIO', 'NWC'),
        feature_group_count=CONV_W) + dw_b.astype(h.dtype)
    hf = h.astype(jnp.float32)
    mu = jnp.mean(hf, axis=-1, keepdims=True)
    var = jnp.mean(jnp.square(hf - mu), axis=-1, keepdims=True)
    hn = (hf - mu) * lax.rsqrt(var + EPS) * ln_g.astype(jnp.float32) + ln_b.astype(jnp.float32)
    return jax.nn.silu(hn).astype(u.dtype)


def retention_scan(q, k, v, log_g, strict):
    B, H, S, D = q.shape
    C = RET_CHUNK
    N = S // C
    qc = q.reshape(B, H, N, C, D)
    kc = k.reshape(B, H, N, C, D)
    vc = v.reshape(B, H, N, C, D)
    idx = jnp.arange(C, dtype=jnp.float32)
    diff = idx[:, None] - idx[None, :]
    mask = (diff > 0) if strict else (diff >= 0)
    decay_in = jnp.where(mask[None], jnp.exp(log_g[:, None, None] * jnp.maximum(diff, 0.0)[None]), 0.0)
    s = jnp.einsum('bhnid,bhnjd->bhnij', qc, kc) * decay_in[None, :, None]
    inner = jnp.einsum('bhnij,bhnjd->bhnid', s, vc)
    k_dec = jnp.exp(log_g[:, None] * (C - 1 - idx)[None, :])
    kv = jnp.einsum('bhnjd,bhnje->nbhde', kc * k_dec[None, :, None, :, None], vc)
    chunk_dec = jnp.exp(log_g * C)[None, :, None, None]

    def step(state, kv_n):
        return chunk_dec * state + kv_n, state

    _, prev = lax.scan(step, jnp.zeros((B, H, D, D), q.dtype), kv)
    q_dec = jnp.exp(log_g[:, None] * (idx + 1.0)[None, :])
    cross = jnp.einsum('bhnid,nbhde->bhnie', qc * q_dec[None, :, None, :, None], prev)
    return (inner + cross).reshape(B, H, S, D)


def retention_branch(u_qkv, decay_logit, cos, sin):
    B, S, _ = u_qkv.shape
    q, k, v = jnp.split(u_qkv, 3, axis=-1)
    q = q.reshape(B, S, RET_HEADS, RET_HD)
    k = k.reshape(B, S, RET_HEADS, RET_HD)
    v = v.reshape(B, S, RET_HEADS, RET_HD)
    q = apply_rope(q, cos[:, None, :], sin[:, None, :])
    k = apply_rope(k, cos[:, None, :], sin[:, None, :]) * (RET_HD ** -0.5)
    q, k, v = [t.transpose(0, 2, 1, 3).astype(jnp.float32) for t in (q, k, v)]
    log_g = jax.nn.log_sigmoid(decay_logit.astype(jnp.float32))
    flip = lambda t: jnp.flip(t, axis=2)
    o = retention_scan(q, k, v, log_g[0], False) + flip(
        retention_scan(flip(q), flip(k), flip(v), log_g[1], True))
    mu = jnp.mean(o, axis=-1, keepdims=True)
    var = jnp.mean(jnp.square(o - mu), axis=-1, keepdims=True)
    o = (o - mu) * lax.rsqrt(var + EPS)
    return o.transpose(0, 2, 1, 3).reshape(B, S, RET_W).astype(u_qkv.dtype)


def mla_branch(q_lat, kv_lat, k_rope_raw, qa_g, w_uq, kva_g, w_ukv, cos, sin):
    B, S, _ = q_lat.shape
    q = (rmsnorm(q_lat, qa_g) @ w_uq).reshape(B, S, MLA_HEADS, MLA_NOPE + MLA_ROPE)
    q_nope = q[..., :MLA_NOPE]
    q_rope = apply_rope(q[..., MLA_NOPE:], cos[:, None, :], sin[:, None, :])
    kv = (rmsnorm(kv_lat, kva_g) @ w_ukv).reshape(B, S, MLA_HEADS, MLA_NOPE + MLA_V_HD)
    k_nope = kv[..., :MLA_NOPE]
    v = kv[..., MLA_NOPE:]
    k_rope = apply_rope(k_rope_raw, cos, sin)
    scale = (MLA_NOPE + MLA_ROPE) ** -0.5
    nb = S // ATTN_BLOCK

    def to_blocks(t):
        return t.reshape(B, nb, ATTN_BLOCK, *t.shape[2:]).swapaxes(0, 1)

    def attend(blk):
        qn, qr = blk
        s = (jnp.einsum('bqhd,bkhd->bhqk', qn, k_nope)
             + jnp.einsum('bqhr,bkr->bhqk', qr, k_rope))
        p = jax.nn.softmax(s.astype(jnp.float32) * scale, axis=-1).astype(v.dtype)
        return jnp.einsum('bhqk,bkhd->bqhd', p, v)

    o = lax.map(attend, (to_blocks(q_nope), to_blocks(q_rope)))
    return o.swapaxes(0, 1).reshape(B, S, MLA_W)


def setup_inputs(seed: int = 0) -> dict:
    key = jax.random.key(seed)
    ks = jax.random.split(key, 16)
    f32 = jnp.float32
    nrm = lambda k, shape, s: jax.random.normal(k, shape, f32) * s
    base_logit = jnp.log(2.0 ** (5.0 + jnp.arange(RET_HEADS, dtype=f32)) - 1.0)
    return {
        "x": nrm(ks[0], (BATCH, SEQ, D_MODEL), 1.0),
        "norm_g": 1.0 + nrm(ks[1], (DEPTH, D_MODEL), 0.02),
        "w_in": nrm(ks[2], (DEPTH, D_MODEL, N_IN), D_MODEL ** -0.5),
        "conv_dw_w": nrm(ks[3], (DEPTH, CONV_K, CONV_W), CONV_K ** -0.5),
        "conv_dw_b": nrm(ks[4], (DEPTH, CONV_W), 0.02),
        "conv_ln_g": 1.0 + nrm(ks[5], (DEPTH, CONV_W), 0.02),
        "conv_ln_b": nrm(ks[6], (DEPTH, CONV_W), 0.02),
        "ret_decay_logit": base_logit[None, None, :] + nrm(ks[7], (DEPTH, 2, RET_HEADS), 0.1),
        "mla_qa_g": 1.0 + nrm(ks[8], (DEPTH, MLA_Q_RANK), 0.02),
        "mla_w_uq": nrm(ks[9], (DEPTH, MLA_Q_RANK, MLA_HEADS * (MLA_NOPE + MLA_ROPE)), MLA_Q_RANK ** -0.5),
        "mla_kva_g": 1.0 + nrm(ks[10], (DEPTH, MLA_KV_RANK), 0.02),
        "mla_w_ukv": nrm(ks[11], (DEPTH, MLA_KV_RANK, MLA_HEADS * (MLA_NOPE + MLA_V_HD)), MLA_KV_RANK ** -0.5),
        "w_out": nrm(ks[12], (DEPTH, D_MIX, D_MODEL), D_MIX ** -0.5),
        "final_g": 1.0 + nrm(ks[13], (D_MODEL,), 0.02),
    }


def reference(x, norm_g, w_in, conv_dw_w, conv_dw_b, conv_ln_g, conv_ln_b, ret_decay_logit,
              mla_qa_g, mla_w_uq, mla_kva_g, mla_w_ukv, w_out, final_g):
    S = x.shape[1]
    cos_r, sin_r = rope_tables(S, RET_HD, x.dtype)
    cos_m, sin_m = rope_tables(S, MLA_ROPE, x.dtype)
    for l in range(DEPTH):
        h = rmsnorm(x, norm_g[l])
        u = h @ w_in[l]
        u_conv, u_ret, u_q, u_kv, u_kr, u_gate = jnp.split(u, SPLIT_POINTS, axis=-1)
        y_conv = conv_module(u_conv, conv_dw_w[l], conv_dw_b[l], conv_ln_g[l], conv_ln_b[l])
        y_ret = retention_branch(u_ret, ret_decay_logit[l], cos_r, sin_r)
        y_mla = mla_branch(u_q, u_kv, u_kr, mla_qa_g[l], mla_w_uq[l], mla_kva_g[l], mla_w_ukv[l], cos_m, sin_m)
        y = jnp.concatenate([y_conv, y_ret, y_mla], axis=-1) * jax.nn.silu(u_gate)
        x = x + y @ w_out[l]
    return rmsnorm(x, final_g)
```

```cpp
#include <hip/hip_runtime.h>
#include <hip/hip_bf16.h>
#include <hip/hip_cooperative_groups.h>
#include <cstdio>
#include <cstdint>
namespace cg = cooperative_groups;

#ifndef REP_B
#define REP_B 1
#endif
#ifndef REP_UP
#define REP_UP 1
#endif
#ifndef REP_MLA
#define REP_MLA 1
#endif
#ifndef REP_RET
#define REP_RET 1
#endif
#ifndef REP_SYNC
#define REP_SYNC 1
#endif
#ifndef REP_CONV
#define REP_CONV 1
#endif
#ifndef REP_ROPE
#define REP_ROPE 1
#endif
#ifndef REP_PREP
#define REP_PREP 1
#endif
#ifndef REP_NORM
#define REP_NORM 1
#endif
#ifndef REP_PB
#define REP_PB 1
#endif
#ifndef REP_E0
#define REP_E0 1
#endif
#ifndef MK_COOP
#define MK_COOP 1
#endif

typedef unsigned short u16;
using bf16x8 = __attribute__((ext_vector_type(8))) short;
using s16x4  = __attribute__((ext_vector_type(4))) short;
using f32x16 = __attribute__((ext_vector_type(16))) float;
using f32x4  = __attribute__((ext_vector_type(4))) float;
using u32x4  = __attribute__((ext_vector_type(4))) unsigned;
using u32x2  = __attribute__((ext_vector_type(2))) unsigned;

constexpr int NTHR = 512;
constexpr int SEQ = 2048, DM = 1024, NIN = 5312;
constexpr int MH = 8192;
constexpr int NU = 3328;
constexpr int NINP = 5376;
constexpr int NYT = 26;
constexpr int NYT2 = 13;
constexpr float EPS = 1e-6f;

constexpr size_t OFF_WIN  = 0;
constexpr size_t OFF_WUQ  = OFF_WIN  + (size_t)2 * NINP * 1024 * 2;
constexpr size_t OFF_WUKV = OFF_WUQ  + (size_t)2 * 1536 * 384 * 2;
constexpr size_t OFF_WOUT = OFF_WUKV + (size_t)2 * 2048 * 256 * 2;
constexpr size_t OFF_COSR = OFF_WOUT + (size_t)2 * 1024 * 2048 * 2;
constexpr size_t OFF_SINR = OFF_COSR + (size_t)2048 * 64 * 4;
constexpr size_t OFF_COSM = OFF_SINR + (size_t)2048 * 64 * 4;
constexpr size_t OFF_SINM = OFF_COSM + (size_t)2048 * 32 * 4;
constexpr size_t OFF_XN   = OFF_SINM + (size_t)2048 * 32 * 4;
constexpr size_t OFF_U    = OFF_XN   + (size_t)2 * MH * 1024 * 2;
constexpr size_t OFF_Y    = OFF_U    + (size_t)MH * NU * 2;
constexpr size_t OFF_Q    = OFF_Y    + (size_t)2 * MH * 2048 * 2;
constexpr size_t OFF_KV   = OFF_Q    + (size_t)MH * 1536 * 2;
constexpr size_t OFF_BAR  = OFF_KV   + (size_t)MH * 2048 * 2;
constexpr size_t OFF_LG2  = OFF_BAR  + 16384;
constexpr size_t OFF_K3   = OFF_LG2  + 256;
constexpr size_t K3_IMG   = (size_t)MH * 512;
constexpr size_t OFF_PST  = OFF_K3   + K3_IMG * 2;
constexpr size_t OFF_SSQ  = OFF_PST  + (size_t)16 * 8 * 2 * 16384 * 2;
constexpr size_t OFF_SSQF = OFF_SSQ  + (size_t)4 * MH * 4;
constexpr size_t WS_END   = OFF_SSQF + (size_t)2 * MH * 4;

constexpr int LDS_BYTES = 131072;

struct Params {
  const float* in[14];
  float* out;
  char* ws;
};

__device__ __forceinline__ unsigned cvtpk(float lo, float hi) {
  unsigned r; asm volatile("v_cvt_pk_bf16_f32 %0, %1, %2" : "=v"(r) : "v"(lo), "v"(hi)); return r;
}
__device__ __forceinline__ float bf2f(u16 v) { return __uint_as_float(((unsigned)v) << 16); }
__device__ __forceinline__ float bflo(unsigned w) { return __uint_as_float(w << 16); }
__device__ __forceinline__ float bfhi(unsigned w) { return __uint_as_float(w & 0xffff0000u); }
__device__ __forceinline__ u16 f2bf(float f) { return (u16)(cvtpk(f, f) & 0xffffu); }
__device__ __forceinline__ float siluf(float x) { return x * __builtin_amdgcn_rcpf(1.f + __expf(-x)); }
__device__ __forceinline__ int crow(int r, int hi) { return (r & 3) + 8 * (r >> 2) + 4 * hi; }
__device__ __forceinline__ float wave_sum(float v) {
#pragma unroll
  for (int m = 32; m >= 1; m >>= 1) v += __shfl_xor(v, m);
  return v;
}
#define SBAR() __builtin_amdgcn_sched_barrier(0)
#define LAS __attribute__((address_space(3)))
__host__ __device__ __forceinline__ int wperm(int c) { return (c & ~31) + ((c >> 2) & 1) * 16 + ((c >> 3) & 3) * 4 + (c & 3); }
__device__ __forceinline__ int TID() { int t = threadIdx.x; asm volatile("" : "+v"(t)); return t; }
__device__ __forceinline__ int BID() { int b = blockIdx.x; asm volatile("" : "+s"(b)); return b; }

struct TJob { const float* src; const float* g; u16* dst; int K, N, k0, n0, n0d; };
__device__ __forceinline__ void tjob_decode(const Params& p, char* ws, int t, TJob& j) {
  int l = t / 2112, r = t % 2112;
  if (r < 1328) { int kt = r / 83, nt = r % 83; int n0 = nt * 64;
    j.src = p.in[2] + (size_t)l * 1024 * NIN; j.g = p.in[1] + l * 1024; j.dst = (u16*)(ws + OFF_WIN) + (size_t)l * NINP * 1024; j.K = 1024; j.N = NIN; j.k0 = kt * 64; j.n0 = n0; j.n0d = n0 < 3264 ? n0 : n0 + 64;
  } else if (r < 1328 + 144) { r -= 1328; int kt = r / 24, nt = r % 24;
    j.src = p.in[9] + (size_t)l * 384 * 1536; j.g = p.in[8] + l * 384; j.dst = (u16*)(ws + OFF_WUQ) + (size_t)l * 1536 * 384; j.K = 384; j.N = 1536; j.k0 = kt * 64; j.n0 = nt * 64; j.n0d = nt * 64;
  } else if (r < 1328 + 144 + 128) { r -= 1328 + 144; int kt = r / 32, nt = r % 32;
    j.src = p.in[11] + (size_t)l * 256 * 2048; j.g = p.in[10] + l * 256; j.dst = (u16*)(ws + OFF_WUKV) + (size_t)l * 2048 * 256; j.K = 256; j.N = 2048; j.k0 = kt * 64; j.n0 = nt * 64; j.n0d = nt * 64;
  } else { r -= 1328 + 144 + 128; int kt = r / 16, nt = r % 16;
    j.src = p.in[12] + (size_t)l * 2048 * 1024; j.g = nullptr; j.dst = (u16*)(ws + OFF_WOUT) + (size_t)l * 1024 * 2048; j.K = 2048; j.N = 1024; j.k0 = kt * 64; j.n0 = nt * 64; j.n0d = nt * 64; }
}
__device__ __forceinline__ void tjob_load(const TJob& j, int tid, float (&v)[8]) {
  const int nn = tid & 63, kq = tid >> 6;
#pragma unroll
  for (int i = 0; i < 8; ++i) { const int kk = kq + 8 * i; float x = j.src[(size_t)(j.k0 + kk) * j.N + j.n0 + nn]; if (j.g) x *= j.g[j.k0 + kk]; v[i] = x; }
}
__device__ void phase_prep(const Params& p, char* lds) {
  char* ws = p.ws;
  {
    float* ts = (float*)lds;
    const int tid = TID();
    const int G = gridDim.x;
    for (int base = BID(); base < 2 * 2112; base += 6 * G) {
      TJob jb[6]; float v[6][8];
#pragma unroll
      for (int i = 0; i < 6; ++i) { const int t = base + i * G; if (t < 2 * 2112) { tjob_decode(p, ws, t, jb[i]); tjob_load(jb[i], tid, v[i]); } }
      { const int nn = tid & 63, kq = tid >> 6;
#pragma unroll
        for (int i = 0; i < 6; ++i) { if (base + i * G < 2 * 2112) {
#pragma unroll
          for (int q = 0; q < 8; ++q) ts[i * 4160 + (kq + 8 * q) * 65 + nn] = v[i][q]; } } }
      __syncthreads();
      { const int nn = tid >> 3, kc = (tid & 7) * 8;
#pragma unroll
        for (int i = 0; i < 6; ++i) { if (base + i * G < 2 * 2112) {
          const float* tt = ts + i * 4160;
          u32x4 w;
          w[0] = cvtpk(tt[(kc + 0) * 65 + nn], tt[(kc + 1) * 65 + nn]);
          w[1] = cvtpk(tt[(kc + 2) * 65 + nn], tt[(kc + 3) * 65 + nn]);
          w[2] = cvtpk(tt[(kc + 4) * 65 + nn], tt[(kc + 5) * 65 + nn]);
          w[3] = cvtpk(tt[(kc + 6) * 65 + nn], tt[(kc + 7) * 65 + nn]);
          *reinterpret_cast<u32x4*>(jb[i].dst + (size_t)wperm(jb[i].n0d + nn) * jb[i].K + jb[i].k0 + kc) = w; } } }
      __syncthreads();
    }
  }
  const int gtid = BID() * NTHR + TID(), gn = gridDim.x * NTHR;
  for (int i = gtid; i < 2 * 32768; i += gn) {
    int l = i >> 15, o = i & 32767;
    ((unsigned*)(ws + OFF_WIN + ((size_t)l * NINP + 3264) * 1024 * 2))[o] = 0u;
  }
  if (gtid < 16) ((float*)(ws + OFF_LG2))[gtid] = -log1pf(expf(-p.in[7][gtid])) * 1.4426950408889634f;
  float* cosr = (float*)(ws + OFF_COSR); float* sinr = (float*)(ws + OFF_SINR);
  float* cosm = (float*)(ws + OFF_COSM); float* sinm = (float*)(ws + OFF_SINM);
  for (int i = gtid; i < 2048 * 64; i += gn) {
    int s = i >> 6, d = i & 63;
    float inv = 1.0f / powf(10000.0f, (float)(2 * d) / 128.0f);
    float ang = (float)s * inv;
    cosr[i] = cosf(ang); sinr[i] = sinf(ang);
  }
  for (int i = gtid; i < 2048 * 32; i += gn) {
    int s = i >> 5, d = i & 31;
    float inv = 1.0f / powf(10000.0f, (float)(2 * d) / 64.0f);
    float ang = (float)s * inv;
    cosm[i] = cosf(ang); sinm[i] = sinf(ang);
  }
}

__device__ void phase_norm(const float* __restrict__ X, u16* __restrict__ XN, int blk, int nblk, int row_lo = 0, int row_hi = MH) {
  const int tid_ = TID(); const int wid = tid_ >> 6, lane = tid_ & 63;
  for (int row = row_lo + blk * 8 + wid; row < row_hi; row += nblk * 8) {
    const f32x4* xr = (const f32x4*)(X + (size_t)row * DM);
    f32x4 v[4]; float ss = 0.f;
#pragma unroll
    for (int i = 0; i < 4; ++i) { v[i] = __builtin_nontemporal_load(xr + lane + 64 * i); ss += v[i][0] * v[i][0] + v[i][1] * v[i][1] + v[i][2] * v[i][2] + v[i][3] * v[i][3]; }
    ss = wave_sum(ss);
    float rstd = rsqrtf(ss * (1.0f / DM) + EPS);
#pragma unroll
    for (int i = 0; i < 4; ++i) {
      u32x2 w; w[0] = cvtpk(v[i][0] * rstd, v[i][1] * rstd); w[1] = cvtpk(v[i][2] * rstd, v[i][3] * rstd);
      *reinterpret_cast<u32x2*>(XN + (size_t)row * DM + (lane + 64 * i) * 4) = w;
    }
  }
}
__device__ void phase_norm2(const float* __restrict__ X, u16* __restrict__ XN, int blk, int nblk) {
  const int tid_ = TID(); const int wid = tid_ >> 6, lane = tid_ & 63;
  const int rstep = nblk * 8;
  for (int row0 = blk * 8 + wid; row0 < MH; row0 += 2 * rstep) {
    f32x4 v[2][4];
#pragma unroll
    for (int q = 0; q < 2; ++q) {
      const int row = row0 + q * rstep;
      if (row < MH) {
        const f32x4* xr = (const f32x4*)(X + (size_t)row * DM);
#pragma unroll
        for (int i = 0; i < 4; ++i) v[q][i] = __builtin_nontemporal_load(xr + lane + 64 * i);
      }
    }
#pragma unroll
    for (int q = 0; q < 2; ++q) {
      const int row = row0 + q * rstep;
      if (row < MH) {
        float ss = 0.f;
#pragma unroll
        for (int i = 0; i < 4; ++i) ss += v[q][i][0] * v[q][i][0] + v[q][i][1] * v[q][i][1] + v[q][i][2] * v[q][i][2] + v[q][i][3] * v[q][i][3];
        ss = wave_sum(ss);
        const float rstd = rsqrtf(ss * (1.0f / DM) + EPS);
#pragma unroll
        for (int i = 0; i < 4; ++i) {
          u32x2 w; w[0] = cvtpk(v[q][i][0] * rstd, v[q][i][1] * rstd); w[1] = cvtpk(v[q][i][2] * rstd, v[q][i][3] * rstd);
          *reinterpret_cast<u32x2*>(XN + (size_t)row * DM + (lane + 64 * i) * 4) = w;
        }
      }
    }
  }
}
__device__ void phase_final(float* __restrict__ X, const float* __restrict__ g) {
  const int tid_ = TID(); const int wid = tid_ >> 6, lane = tid_ & 63;
  for (int row = BID() * 8 + wid; row < 2 * MH; row += gridDim.x * 8) {
    f32x4* xr = (f32x4*)(X + (size_t)row * DM);
    f32x4 v[4]; float ss = 0.f;
#pragma unroll
    for (int i = 0; i < 4; ++i) { v[i] = xr[lane + 64 * i]; ss += v[i][0] * v[i][0] + v[i][1] * v[i][1] + v[i][2] * v[i][2] + v[i][3] * v[i][3]; }
    ss = wave_sum(ss);
    float rstd = rsqrtf(ss * (1.0f / DM) + EPS);
#pragma unroll
    for (int i = 0; i < 4; ++i) {
      f32x4 gg = ((const f32x4*)g)[lane + 64 * i];
      f32x4 o; o[0] = v[i][0] * rstd * gg[0]; o[1] = v[i][1] * rstd * gg[1]; o[2] = v[i][2] * rstd * gg[2]; o[3] = v[i][3] * rstd * gg[3];
      xr[lane + 64 * i] = o;
    }
  }
}

constexpr int GA_BYTES = 256 * 144, GB_BYTES = 128 * 144;
__device__ __forceinline__ int gswz(int row, int chunk) { return row * 144 + (chunk << 4); }

enum { EPI_IN = 0, EPI_Q = 1, EPI_KV = 2, EPI_OUT = 3 };
struct XcdBarrier;
__device__ __forceinline__ void xcd_barrier(const XcdBarrier& b);
struct EpiArgs {
  u16* c0; u16* c1;
  const float* resid; float* xout;
  const float* cosm; const float* sinm;
  float* ssq_q; float* ssq_kv;
  const XcdBarrier* xb; float* ssqf; const float* fg; int fuse; u16* xn_out;
};

template <int EPI, bool NORM>
__device__ __forceinline__ void gemm_tile(const u16* __restrict__ A, int lda, const u16* __restrict__ Bt, int K, int m0, int n0, char* lds, const EpiArgs& ea) {
  const int tid = TID(), wid = tid >> 6, lane = tid & 63, r32 = lane & 31, hi = lane >> 5;
  const int wm = wid >> 1, wn = wid & 1;
  char* As = lds; char* Bs = lds + 2 * GA_BYTES; float* rs = (float*)(lds + 2 * GA_BYTES + 2 * GB_BYTES);
  const int srow = tid >> 3, sch = tid & 7;
  const u16* Ag = A + (size_t)(m0 + srow) * lda + sch * 8;
  const u16* Bg = Bt + (size_t)(n0 + srow) * K + sch * 8;
  f32x16 acc[2][2];
#pragma unroll
  for (int i = 0; i < 2; ++i)
#pragma unroll
    for (int j = 0; j < 2; ++j)
#pragma unroll
      for (int r = 0; r < 16; ++r) acc[i][j][r] = 0.f;
  float ss[4] = {0.f, 0.f, 0.f, 0.f};
  bf16x8 ra[4], rb[2];
#pragma unroll
  for (int i = 0; i < 4; ++i) ra[i] = *reinterpret_cast<const bf16x8*>(Ag + (size_t)i * 64 * lda);
#pragma unroll
  for (int i = 0; i < 2; ++i) rb[i] = *reinterpret_cast<const bf16x8*>(Bg + (size_t)i * 64 * K);
  const int KT = K >> 6;
#define GWRITE(buf) do { \
    _Pragma("unroll") for (int i = 0; i < 4; ++i) { \
      *reinterpret_cast<bf16x8*>(As + (buf) * GA_BYTES + gswz(srow + 64 * i, sch)) = ra[i]; \
      if (NORM) { _Pragma("unroll") for (int j = 0; j < 8; ++j) { float f = bf2f((u16)ra[i][j]); ss[i] += f * f; } } } \
    _Pragma("unroll") for (int i = 0; i < 2; ++i) *reinterpret_cast<bf16x8*>(Bs + (buf) * GB_BYTES + gswz(srow + 64 * i, sch)) = rb[i]; } while (0)
  GWRITE(0);
  __syncthreads();
  for (int kt = 0; kt < KT; ++kt) {
    const int cur = kt & 1;
    if (kt + 1 < KT) {
      const int k0 = (kt + 1) * 64;
#pragma unroll
      for (int i = 0; i < 4; ++i) ra[i] = *reinterpret_cast<const bf16x8*>(Ag + (size_t)i * 64 * lda + k0);
#pragma unroll
      for (int i = 0; i < 2; ++i) rb[i] = *reinterpret_cast<const bf16x8*>(Bg + (size_t)i * 64 * K + k0);
    }
    SBAR();
    const char* Ab = As + cur * GA_BYTES; const char* Bb = Bs + cur * GB_BYTES;
#pragma unroll
    for (int ks = 0; ks < 4; ++ks) {
      const int ch = ks * 2 + hi;
      bf16x8 a0 = *reinterpret_cast<const bf16x8*>(Ab + gswz(wm * 64 + r32, ch));
      bf16x8 a1 = *reinterpret_cast<const bf16x8*>(Ab + gswz(wm * 64 + 32 + r32, ch));
      bf16x8 b0 = *reinterpret_cast<const bf16x8*>(Bb + gswz(wn * 64 + r32, ch));
      bf16x8 b1 = *reinterpret_cast<const bf16x8*>(Bb + gswz(wn * 64 + 32 + r32, ch));
      acc[0][0] = __builtin_amdgcn_mfma_f32_32x32x16_bf16(a0, b0, acc[0][0], 0, 0, 0);
      acc[0][1] = __builtin_amdgcn_mfma_f32_32x32x16_bf16(a0, b1, acc[0][1], 0, 0, 0);
      acc[1][0] = __builtin_amdgcn_mfma_f32_32x32x16_bf16(a1, b0, acc[1][0], 0, 0, 0);
      acc[1][1] = __builtin_amdgcn_mfma_f32_32x32x16_bf16(a1, b1, acc[1][1], 0, 0, 0);
    }
    SBAR();
    if (kt + 1 < KT) GWRITE(cur ^ 1);
    __syncthreads();
  }
#undef GWRITE
  if (NORM) {
#pragma unroll
    for (int i = 0; i < 4; ++i) {
      float s = ss[i];
      s += __shfl_xor(s, 1); s += __shfl_xor(s, 2); s += __shfl_xor(s, 4);
      if (sch == 0) rs[srow + 64 * i] = rsqrtf(s / (float)K + EPS);
    }
    __syncthreads();
  }
  if (EPI == EPI_IN) {
    const bool gate = n0 >= NYT * 128;
#pragma unroll
    for (int mi = 0; mi < 2; ++mi)
#pragma unroll
      for (int r = 0; r < 16; ++r) {
        const int row = m0 + wm * 64 + mi * 32 + crow(r, hi);
#pragma unroll
        for (int ni = 0; ni < 2; ++ni) {
          const int col = n0 + wn * 64 + ni * 32 + r32;
          float v = acc[mi][ni][r];
          if (gate) ea.c1[(size_t)row * 2048 + (col - NYT * 128)] = f2bf(siluf(v));
          else ea.c0[(size_t)row * NU + col] = f2bf(v);
        }
      }
  } else if (EPI == EPI_Q) {
    const bool rope = ((n0 + wn * 64) % 192) == 128;
#pragma unroll
    for (int mi = 0; mi < 2; ++mi)
#pragma unroll
      for (int r = 0; r < 16; ++r) {
        const int rl = wm * 64 + mi * 32 + crow(r, hi);
        const int row = m0 + rl;
        const float sc = rs[rl];
        float v0 = acc[mi][0][r] * sc, v1 = acc[mi][1][r] * sc;
        if (rope) {
          const int s = row & (SEQ - 1);
          const float c = ea.cosm[s * 32 + r32], sn = ea.sinm[s * 32 + r32];
          const float o0 = v0 * c - v1 * sn, o1 = v1 * c + v0 * sn;
          v0 = o0; v1 = o1;
        }
        const int col = n0 + wn * 64 + r32;
        ea.c0[(size_t)row * 1536 + col] = f2bf(v0);
        ea.c0[(size_t)row * 1536 + col + 32] = f2bf(v1);
      }
  } else if (EPI == EPI_KV) {
#pragma unroll
    for (int mi = 0; mi < 2; ++mi)
#pragma unroll
      for (int r = 0; r < 16; ++r) {
        const int rl = wm * 64 + mi * 32 + crow(r, hi);
        const int row = m0 + rl;
        const float sc = rs[rl];
        const int col = n0 + wn * 64 + r32;
        ea.c0[(size_t)row * 2048 + col] = f2bf(acc[mi][0][r] * sc);
        ea.c0[(size_t)row * 2048 + col + 32] = f2bf(acc[mi][1][r] * sc);
      }
  } else {
#pragma unroll
    for (int mi = 0; mi < 2; ++mi)
#pragma unroll
      for (int r = 0; r < 16; ++r) {
        const int row = m0 + wm * 64 + mi * 32 + crow(r, hi);
        const int col = n0 + wn * 64 + r32;
        const size_t o = (size_t)row * DM + col;
        ea.xout[o] = ea.resid[o] + acc[mi][0][r];
        ea.xout[o + 32] = ea.resid[o + 32] + acc[mi][1][r];
      }
  }
  if (NORM) __syncthreads();
}

constexpr int HTB = 128 * 64 * 2;
__device__ __forceinline__ int lds_byte(int r, int c) { const int st = (r >> 4) * 2 + (c >> 5), rr = r & 15, cc = c & 31, ob = rr * 64 + cc * 2; return st * 1024 + (ob ^ (((ob >> 9) & 1) << 5)); }
__device__ __forceinline__ void stage_rc(int b, int& R, int& C) { const int st = b / 1024, sb = b % 1024, swz = sb ^ (((sb >> 9) & 1) << 5); R = (st >> 1) * 16 + swz / 64; C = (st & 1) * 32 + (swz % 64) / 2; }

enum { EPI2_IN = 0, EPI2_OUT = 1, EPI2_Q = 2, EPI2_KV = 3, EPI2_OUTF = 4 };
__device__ __forceinline__ int nt_remap(int v) { return v < 9 ? v + 4 : (v < 16 ? v + 5 : (v == 20 ? 13 : v - 16)); }
template <int EPI, bool REMAP = false>
__device__ __forceinline__ void gemm256_tiles(const u16* __restrict__ A, int lda, const u16* __restrict__ Bt, int K, int t0, int t1, int tstep, int xcd, int mbits, char* shm, const EpiArgs& ea) {
  if (t0 >= t1) return;
  const int tid = TID(), wid = tid >> 6, lane = tid & 63, wr = wid >> 2, wc = wid & 3, fr = lane & 15, fq = lane >> 4;
  int r0, c0; stage_rc(tid * 16, r0, c0);
  int tcur = t0;
  int brow = ((xcd << mbits) + (tcur & ((1 << mbits) - 1))) * 256, bcol = (REMAP ? nt_remap(tcur >> mbits) : (tcur >> mbits)) * 256;
  const size_t ahalf = (size_t)128 * lda, bhalf = (size_t)128 * K, aq = (size_t)64 * lda, bq = (size_t)64 * K;
  char* sdst = shm + tid * 16;
#define SA(b, h) (((b) * 2 + (h)) * HTB)
#define SB(b, h) ((4 + (b) * 2 + (h)) * HTB)
#define GLDS(g, off) __builtin_amdgcn_global_load_lds((const unsigned*)(g), (LAS unsigned*)(sdst + (off)), 16, 0, 0)
#define STAGE_AP(P_, off, h, kt) do { GLDS((P_) + (h) * ahalf + (kt) * 64, (off)); GLDS((P_) + aq + (h) * ahalf + (kt) * 64, (off) + 8192); } while (0)
#define STAGE_BP(P_, off, h, kt) do { GLDS((P_) + (h) * bhalf + (kt) * 64, (off)); GLDS((P_) + bq + (h) * bhalf + (kt) * 64, (off) + 8192); } while (0)
#define STAGE_A(off, h, kt) STAGE_AP(Ag0, off, h, kt)
#define STAGE_B(off, h, kt) STAGE_BP(Bg0, off, h, kt)
#define LDA(dst, b, h) _Pragma("unroll") for (int m = 0; m < 4; ++m) _Pragma("unroll") for (int k = 0; k < 2; ++k) \
    dst[m][k] = *reinterpret_cast<const bf16x8*>(shm + SA(b, h) + lds_byte(wr * 64 + m * 16 + fr, k * 32 + fq * 8))
#define LDB(dst, b, h) _Pragma("unroll") for (int n = 0; n < 2; ++n) _Pragma("unroll") for (int k = 0; k < 2; ++k) \
    dst[n][k] = *reinterpret_cast<const bf16x8*>(shm + SB(b, h) + lds_byte(wc * 32 + n * 16 + fr, k * 32 + fq * 8))
#define MMA(ai, bj, At_, Bt_) do { __builtin_amdgcn_s_setprio(1); \
    _Pragma("unroll") for (int m = 0; m < 4; ++m) _Pragma("unroll") for (int n = 0; n < 2; ++n) _Pragma("unroll") for (int k = 0; k < 2; ++k) \
      acc[ai][bj][m][n] = __builtin_amdgcn_mfma_f32_16x16x32_bf16(Bt_[n][k], At_[m][k], acc[ai][bj][m][n], 0, 0, 0); \
    __builtin_amdgcn_s_setprio(0); } while (0)
#define WAIT_V(n) asm volatile("s_waitcnt vmcnt(" #n ")" ::: "memory")
#define WAIT_L(n) asm volatile("s_waitcnt lgkmcnt(" #n ")" ::: "memory")
#define BAR __builtin_amdgcn_s_barrier()
#define SCHED __builtin_amdgcn_sched_barrier(0)
  const int nt = K >> 6;
  { const u16* pa_ = A + (size_t)(brow + r0) * lda + c0; const u16* pb_ = Bt + (size_t)(bcol + r0) * K + c0;
    STAGE_BP(pb_, SB(0, 0), 0, 0); STAGE_AP(pa_, SA(0, 0), 0, 0);
    STAGE_BP(pb_, SB(0, 1), 1, 0); STAGE_AP(pa_, SA(0, 1), 1, 0); }
  for (;;) {
  const u16* Ag0; const u16* Bg0;
  { int r0n, c0n; stage_rc(TID() * 16, r0n, c0n); Ag0 = A + (size_t)(brow + r0n) * lda + c0n; Bg0 = Bt + (size_t)(bcol + r0n) * K + c0n; }
  f32x4 acc[2][2][4][2];
#pragma unroll
  for (int a = 0; a < 2; ++a)
#pragma unroll
    for (int b = 0; b < 2; ++b)
#pragma unroll
      for (int m = 0; m < 4; ++m)
#pragma unroll
        for (int n = 0; n < 2; ++n) acc[a][b][m][n] = (f32x4){0.f, 0.f, 0.f, 0.f};
  bf16x8 At[4][2], B0[2][2], B1[2][2];
  if (wr == 1) BAR;
  WAIT_V(4); BAR;
  STAGE_B(SB(1, 0), 0, 1); STAGE_A(SA(1, 0), 0, 1); STAGE_B(SB(1, 1), 1, 1);
  WAIT_V(6); BAR;
  for (int t = 0; t < nt - 2; t += 2) {
    LDB(B0, 0, 0); SCHED; LDA(At, 0, 0); STAGE_A(SA(1, 1), 1, t + 1);
    WAIT_L(8); BAR; WAIT_L(0); MMA(0, 0, At, B0); BAR; SCHED;
    LDB(B1, 0, 1); STAGE_B(SB(0, 0), 0, t + 2);
    BAR; WAIT_L(0); MMA(0, 1, At, B1); BAR;
    LDA(At, 0, 1); STAGE_A(SA(0, 0), 0, t + 2);
    BAR; WAIT_L(0); MMA(1, 0, At, B0); BAR; SCHED;
    STAGE_B(SB(0, 1), 1, t + 2);
    WAIT_V(6); BAR; MMA(1, 1, At, B1); BAR;
    LDB(B0, 1, 0); SCHED; LDA(At, 1, 0); STAGE_A(SA(0, 1), 1, t + 2);
    WAIT_L(8); BAR; WAIT_L(0); MMA(0, 0, At, B0); BAR; SCHED;
    LDB(B1, 1, 1); STAGE_B(SB(1, 0), 0, t + 3);
    BAR; WAIT_L(0); MMA(0, 1, At, B1); BAR;
    LDA(At, 1, 1); STAGE_A(SA(1, 0), 0, t + 3);
    BAR; WAIT_L(0); MMA(1, 0, At, B0); BAR; SCHED;
    STAGE_B(SB(1, 1), 1, t + 3);
    WAIT_V(6); BAR; MMA(1, 1, At, B1); BAR;
  }
  { LDB(B0, 0, 0); LDA(At, 0, 0); STAGE_A(SA(1, 1), 1, nt - 1);
    BAR; WAIT_L(0); MMA(0, 0, At, B0); BAR;
    LDB(B1, 0, 1); BAR; WAIT_L(0); MMA(0, 1, At, B1); BAR;
    LDA(At, 0, 1); WAIT_V(4); BAR; WAIT_L(0); MMA(1, 0, At, B0); MMA(1, 1, At, B1); BAR; }
  { LDB(B0, 1, 0); LDA(At, 1, 0); WAIT_V(2); BAR; WAIT_L(0); MMA(0, 0, At, B0); BAR;
    LDB(B1, 1, 1); WAIT_V(0); BAR; WAIT_L(0); MMA(0, 1, At, B1); BAR;
    LDA(At, 1, 1); BAR; WAIT_L(0); MMA(1, 0, At, B0); MMA(1, 1, At, B1); BAR; }
  if (wr == 0) BAR;
  const int tnext = tcur + tstep; const bool more = tnext < t1;
  const int cbrow = brow, cbcol = bcol;
  if (more) {
    brow = ((xcd << mbits) + (tnext & ((1 << mbits) - 1))) * 256; bcol = (REMAP ? nt_remap(tnext >> mbits) : (tnext >> mbits)) * 256;
    int r0n, c0n; stage_rc(TID() * 16, r0n, c0n);
    const u16* pa_ = A + (size_t)(brow + r0n) * lda + c0n; const u16* pb_ = Bt + (size_t)(bcol + r0n) * K + c0n;
    STAGE_BP(pb_, SB(0, 0), 0, 0); STAGE_AP(pa_, SA(0, 0), 0, 0);
    STAGE_BP(pb_, SB(0, 1), 1, 0); STAGE_AP(pa_, SA(0, 1), 1, 0);
  }
  {
  const int brow = cbrow, bcol = cbcol;
  const int tid2 = TID(), wid2 = tid2 >> 6, lane2 = tid2 & 63, wr = wid2 >> 2, wc = wid2 & 3, fr = lane2 & 15, fq = lane2 >> 4;
  if (EPI == EPI2_OUTF) {
#pragma unroll
    for (int ai = 0; ai < 2; ++ai)
#pragma unroll
      for (int m = 0; m < 4; ++m) {
        const int row = brow + ai * 128 + wr * 64 + m * 16 + fr;
        float sq = 0.f;
#pragma unroll
        for (int bj = 0; bj < 2; ++bj) {
          const size_t o = (size_t)row * DM + bcol + bj * 128 + wc * 32 + 8 * fq;
          const f32x4 q0 = __builtin_nontemporal_load(reinterpret_cast<const f32x4*>(ea.resid + o)), q1 = __builtin_nontemporal_load(reinterpret_cast<const f32x4*>(ea.resid + o + 4));
          const f32x4 v0 = q0 + acc[ai][bj][m][0], v1 = q1 + acc[ai][bj][m][1];
          acc[ai][bj][m][0] = v0; acc[ai][bj][m][1] = v1;
          sq += v0[0] * v0[0] + v0[1] * v0[1] + v0[2] * v0[2] + v0[3] * v0[3] + v1[0] * v1[0] + v1[1] * v1[1] + v1[2] * v1[2] + v1[3] * v1[3];
        }
        sq += __shfl_xor(sq, 16); sq += __shfl_xor(sq, 32);
        if (fq == 0) atomicAdd(ea.ssqf + row, sq);
      }
    xcd_barrier(*ea.xb);
#pragma unroll
    for (int ai = 0; ai < 2; ++ai)
#pragma unroll
      for (int m = 0; m < 4; ++m) {
        const int row = brow + ai * 128 + wr * 64 + m * 16 + fr;
        const float rstd = rsqrtf(ea.ssqf[row] * (1.0f / DM) + EPS);
#pragma unroll
        for (int bj = 0; bj < 2; ++bj) {
          const int col = bcol + bj * 128 + wc * 32 + 8 * fq;
          if (ea.xn_out) {
            const f32x4 v0 = acc[ai][bj][m][0], v1 = acc[ai][bj][m][1];
            *reinterpret_cast<f32x4*>(ea.xout + (size_t)row * DM + col) = v0;
            *reinterpret_cast<f32x4*>(ea.xout + (size_t)row * DM + col + 4) = v1;
            u32x4 w; w[0] = cvtpk(v0[0] * rstd, v0[1] * rstd); w[1] = cvtpk(v0[2] * rstd, v0[3] * rstd); w[2] = cvtpk(v1[0] * rstd, v1[1] * rstd); w[3] = cvtpk(v1[2] * rstd, v1[3] * rstd);
            *reinterpret_cast<u32x4*>(ea.xn_out + (size_t)row * DM + col) = w;
          } else {
            const f32x4 g0 = *reinterpret_cast<const f32x4*>(ea.fg + col), g1 = *reinterpret_cast<const f32x4*>(ea.fg + col + 4);
            *reinterpret_cast<f32x4*>(ea.xout + (size_t)row * DM + col) = acc[ai][bj][m][0] * rstd * g0;
            *reinterpret_cast<f32x4*>(ea.xout + (size_t)row * DM + col + 4) = acc[ai][bj][m][1] * rstd * g1;
          }
        }
      }
  } else
#pragma unroll
  for (int ai = 0; ai < 2; ++ai)
#pragma unroll
    for (int m = 0; m < 4; ++m) {
      const int row = brow + ai * 128 + wr * 64 + m * 16 + fr;
#pragma unroll
      for (int bj = 0; bj < 2; ++bj) {
        const int col = bcol + bj * 128 + wc * 32 + 8 * fq;
        const f32x4 v0 = acc[ai][bj][m][0], v1 = acc[ai][bj][m][1];
        if (EPI == EPI2_Q || EPI == EPI2_KV) {
          const float ssv = (EPI == EPI2_Q ? ea.ssq_q : ea.ssq_kv)[row];
          const float sc = rsqrtf(ssv * (EPI == EPI2_Q ? (1.0f / 384.0f) : (1.0f / 256.0f)) + EPS);
          u32x4 w;
          w[0] = cvtpk(v0[0] * sc, v0[1] * sc); w[1] = cvtpk(v0[2] * sc, v0[3] * sc); w[2] = cvtpk(v1[0] * sc, v1[1] * sc); w[3] = cvtpk(v1[2] * sc, v1[3] * sc);
          *reinterpret_cast<u32x4*>(ea.c0 + (size_t)row * (EPI == EPI2_Q ? 1536 : 2048) + col) = w;
        } else if (EPI == EPI2_IN) {
          if (bcol >= 2560 && bcol <= 3072) {
            const int cg0 = bcol + bj * 128;
            if (cg0 < 3200) {
              float sq = v0[0] * v0[0] + v0[1] * v0[1] + v0[2] * v0[2] + v0[3] * v0[3] + v1[0] * v1[0] + v1[1] * v1[1] + v1[2] * v1[2] + v1[3] * v1[3];
              sq += __shfl_xor(sq, 16); sq += __shfl_xor(sq, 32);
              if (fq == 0) atomicAdd((cg0 < 2944 ? ea.ssq_q : ea.ssq_kv) + row, sq);
            }
          }
          u32x4 w;
          if (bcol >= NYT2 * 256) {
            w[0] = cvtpk(siluf(v0[0]), siluf(v0[1])); w[1] = cvtpk(siluf(v0[2]), siluf(v0[3]));
            w[2] = cvtpk(siluf(v1[0]), siluf(v1[1])); w[3] = cvtpk(siluf(v1[2]), siluf(v1[3]));
            *reinterpret_cast<u32x4*>(ea.c1 + (size_t)row * 2048 + (col - NYT2 * 256)) = w;
          } else {
            w[0] = cvtpk(v0[0], v0[1]); w[1] = cvtpk(v0[2], v0[3]); w[2] = cvtpk(v1[0], v1[1]); w[3] = cvtpk(v1[2], v1[3]);
            *reinterpret_cast<u32x4*>(ea.c0 + (size_t)row * NU + col) = w;
          }
        } else {
          const size_t o = (size_t)row * DM + col;
          const f32x4 q0 = __builtin_nontemporal_load(reinterpret_cast<const f32x4*>(ea.resid + o)), q1 = __builtin_nontemporal_load(reinterpret_cast<const f32x4*>(ea.resid + o + 4));
          *reinterpret_cast<f32x4*>(ea.xout + o) = q0 + v0;
          *reinterpret_cast<f32x4*>(ea.xout + o + 4) = q1 + v1;
        }
      }
    }
  }
  asm volatile("s_waitcnt vmcnt(0)" ::: "memory");
  __syncthreads();
  if (!more) break;
  tcur = tnext;
  }
#undef SA
#undef SB
#undef GLDS
#undef STAGE_A
#undef STAGE_AP
#undef STAGE_BP
#undef STAGE_B
#undef LDA
#undef LDB
#undef MMA
#undef WAIT_V
#undef WAIT_L
#undef BAR
#undef SCHED
}

__device__ void conv_tile(const u16* __restrict__ U, u16* __restrict__ Y, const float* __restrict__ dw_w, const float* __restrict__ dw_b,
                          const float* __restrict__ ln_g, const float* __restrict__ ln_b, int t0, char* lds, bool dowrite = true) {
  float* hs = (float*)lds;
  const int tid = TID(), wid = tid >> 6, lane = tid & 63;
  const int bb = t0 & ~(SEQ - 1), s0 = t0 & (SEQ - 1);
  {
    u32x4 av[8], gv[8];
#pragma unroll
    for (int it = 0; it < 8; ++it) {
      const int idx = tid + it * NTHR;
      const int rr = idx >> 6, ch = (idx & 63) * 8;
      const int s = s0 - 15 + rr;
      av[it] = (u32x4){0u, 0u, 0u, 0u}; gv[it] = (u32x4){0u, 0u, 0u, 0u};
      if (idx < 62 * 64 && s >= 0 && s < SEQ) {
        const u16* up = U + (size_t)(bb + s) * NU + ch;
        av[it] = *reinterpret_cast<const u32x4*>(up);
        gv[it] = *reinterpret_cast<const u32x4*>(up + 512);
      }
    }
#pragma unroll
    for (int it = 0; it < 8; ++it) {
      const int idx = tid + it * NTHR;
      const int rr = idx >> 6, ch = (idx & 63) * 8;
      if (idx < 62 * 64) {
        f32x4 h0, h1;
#pragma unroll
        for (int j = 0; j < 4; ++j) {
          float a0 = bflo(av[it][j]), a1 = bfhi(av[it][j]), g0 = bflo(gv[it][j]), g1 = bfhi(gv[it][j]);
          float x0 = a0 * __builtin_amdgcn_rcpf(1.f + __expf(-g0)), x1 = a1 * __builtin_amdgcn_rcpf(1.f + __expf(-g1));
          if (j < 2) { h0[2 * j] = x0; h0[2 * j + 1] = x1; } else { h1[2 * (j - 2)] = x0; h1[2 * (j - 2) + 1] = x1; }
        }
        *reinterpret_cast<f32x4*>(hs + rr * 512 + ch) = h0;
        *reinterpret_cast<f32x4*>(hs + rr * 512 + ch + 4) = h1;
      }
    }
  }
  __syncthreads();
  const int c = tid;
  float w[31];
#pragma unroll
  for (int k = 0; k < 31; ++k) w[k] = dw_w[k * 512 + c];
  const float bias = dw_b[c];
  float outv[32];
#pragma unroll
  for (int tb = 0; tb < 4; ++tb) {
    float hv[38];
#pragma unroll
    for (int i = 0; i < 38; ++i) hv[i] = hs[(tb * 8 + i) * 512 + c];
#pragma unroll
    for (int t = 0; t < 8; ++t) {
      float a = bias;
#pragma unroll
      for (int k = 0; k < 31; ++k) a = fmaf(w[k], hv[t + k], a);
      outv[tb * 8 + t] = a;
    }
  }
  __syncthreads();
#pragma unroll
  for (int t = 0; t < 32; ++t) hs[t * 512 + c] = outv[t];
  __syncthreads();
#pragma unroll
  for (int q = 0; q < 4; ++q) {
    const int t = wid * 4 + q;
    const int ch = lane * 8;
    f32x4 v0 = *reinterpret_cast<const f32x4*>(hs + t * 512 + ch);
    f32x4 v1 = *reinterpret_cast<const f32x4*>(hs + t * 512 + ch + 4);
    float x[8] = {v0[0], v0[1], v0[2], v0[3], v1[0], v1[1], v1[2], v1[3]};
    float s = 0.f;
#pragma unroll
    for (int j = 0; j < 8; ++j) s += x[j];
    const float mu = wave_sum(s) * (1.f / 512.f);
    float vs = 0.f;
#pragma unroll
    for (int j = 0; j < 8; ++j) { x[j] -= mu; vs += x[j] * x[j]; }
    const float rstd = rsqrtf(wave_sum(vs) * (1.f / 512.f) + EPS);
    u16* yp = Y + (size_t)(t0 + t) * 2048 + ch;
    u32x4 gt = *reinterpret_cast<const u32x4*>(yp);
    float o[8];
#pragma unroll
    for (int j = 0; j < 8; ++j) {
      float hn = x[j] * rstd * ln_g[ch + j] + ln_b[ch + j];
      float gj = (j & 1) ? bfhi(gt[j >> 1]) : bflo(gt[j >> 1]);
      o[j] = siluf(hn) * gj;
    }
    u32x4 ow; ow[0] = cvtpk(o[0], o[1]); ow[1] = cvtpk(o[2], o[3]); ow[2] = cvtpk(o[4], o[5]); ow[3] = cvtpk(o[6], o[7]);
    if (dowrite) *reinterpret_cast<u32x4*>(yp) = ow;
  }
  __syncthreads();
}

__device__ void rope_rows(u16* __restrict__ U, u16* __restrict__ K3, const float* __restrict__ lg2, const float* __restrict__ cosr, const float* __restrict__ sinr, const float* __restrict__ cosm, const float* __restrict__ sinm, bool dowrite = true) {
  const int t = TID();
  const int isk = t >> 8, hh = (t >> 6) & 3, d = t & 63;
  for (int m = BID(); m < MH; m += gridDim.x) {
    const int s = m & (SEQ - 1);
    u16* base = U + (size_t)m * NU + 1024 + isk * 512 + hh * 128;
    float x1 = bf2f(base[d]), x2 = bf2f(base[d + 64]);
    float c = cosr[s * 64 + d], sn = sinr[s * 64 + d];
    float o1 = x1 * c - x2 * sn, o2 = x2 * c + x1 * sn;
    if (isk) {
      o1 *= 0.08838834764831845f; o2 *= 0.08838834764831845f;
      u16* kd = K3 + (size_t)m * 512 + hh * 128;
      if (dowrite) { kd[d] = f2bf(o1); kd[d + 64] = f2bf(o2); }
    } else if (dowrite) { base[d] = f2bf(o1); base[d + 64] = f2bf(o2); }
    if (t < 32) {
      u16* kb = U + (size_t)m * NU + 3200;
      float y1 = bf2f(kb[t]), y2 = bf2f(kb[t + 32]);
      float cm = cosm[s * 32 + t], sm = sinm[s * 32 + t];
      if (dowrite) { kb[t] = f2bf(y1 * cm - y2 * sm); kb[t + 32] = f2bf(y2 * cm + y1 * sm); }
    }
  }
}

template <int DQK> __device__ __forceinline__ int kswz(int row, int cb) {
  return row * (DQK * 2 + 16) + cb;
}
__device__ __forceinline__ int v_st(int k, int c) { const int kk = (k & ~0xC) | ((k & 4) << 1) | ((k & 8) >> 1); return ((kk >> 3) * 4 + (c >> 5)) * 512 + ((kk & 7) * 32 + (c & 31)) * 2; }
__device__ __forceinline__ int v_rd_base(int lane) { return ((lane & 3) << 3) | (((lane >> 2) & 3) << 6) | (((lane >> 4) & 1) << 5) | (((lane >> 5) & 1) << 8); }
constexpr int v_rd_off(int d0, int ks, int half) { return d0 * 512 + ks * 4096 + half * 2048; }
template <int OFF> __device__ __forceinline__ s16x4 tr_read(int vb) {
  s16x4 r; asm volatile("ds_read_b64_tr_b16 %0, %1 offset:%2" : "=&v"(r) : "v"(vb), "i"(OFF) : "memory"); return r;
}
template <int D0> __device__ __forceinline__ void pv_one(f32x16& od, int vb, bf16x8 pa0, bf16x8 pa1, bf16x8 pa2, bf16x8 pa3) {
  const s16x4 l0 = tr_read<v_rd_off(D0, 0, 0)>(vb), h0 = tr_read<v_rd_off(D0, 0, 1)>(vb), l1 = tr_read<v_rd_off(D0, 1, 0)>(vb), h1 = tr_read<v_rd_off(D0, 1, 1)>(vb);
  const s16x4 l2 = tr_read<v_rd_off(D0, 2, 0)>(vb), h2 = tr_read<v_rd_off(D0, 2, 1)>(vb), l3 = tr_read<v_rd_off(D0, 3, 0)>(vb), h3 = tr_read<v_rd_off(D0, 3, 1)>(vb);
  asm volatile("s_waitcnt lgkmcnt(0)" ::: "memory"); SBAR();
#define PK(L, H) (bf16x8){L[0], L[1], L[2], L[3], H[0], H[1], H[2], H[3]}
  od = __builtin_amdgcn_mfma_f32_32x32x16_bf16(pa0, PK(l0, h0), od, 0, 0, 0);
  od = __builtin_amdgcn_mfma_f32_32x32x16_bf16(pa1, PK(l1, h1), od, 0, 0, 0);
  od = __builtin_amdgcn_mfma_f32_32x32x16_bf16(pa2, PK(l2, h2), od, 0, 0, 0);
  od = __builtin_amdgcn_mfma_f32_32x32x16_bf16(pa3, PK(l3, h3), od, 0, 0, 0);
#undef PK
}
__device__ __forceinline__ void pv_d0(f32x16* o, int vb, bf16x8 pa0, bf16x8 pa1, bf16x8 pa2, bf16x8 pa3) {
  pv_one<0>(o[0], vb, pa0, pa1, pa2, pa3); pv_one<1>(o[1], vb, pa0, pa1, pa2, pa3); pv_one<2>(o[2], vb, pa0, pa1, pa2, pa3); pv_one<3>(o[3], vb, pa0, pa1, pa2, pa3);
}
constexpr float MLA_SCALE = 0.07216878364870322f;
constexpr float MLA_THR = 8.f;
__device__ __forceinline__ void partialSM(f32x16& p0, f32x16& p1, float& m_reg, float& mn, float& alpha) {
  constexpr float C = MLA_SCALE * 1.4426950408889634f;
  float pmax = p0[0];
#pragma unroll
  for (int r = 1; r < 16; ++r) pmax = fmaxf(pmax, p0[r]);
#pragma unroll
  for (int r = 0; r < 16; ++r) pmax = fmaxf(pmax, p1[r]);
  { auto rr = __builtin_amdgcn_permlane32_swap(__float_as_uint(pmax), __float_as_uint(pmax), false, false);
    pmax = fmaxf(__uint_as_float(rr[0]), __uint_as_float(rr[1])); }
  if (__builtin_expect(__all(pmax - m_reg <= MLA_THR / MLA_SCALE), 1)) { mn = m_reg; alpha = 1.f; }
  else { mn = fmaxf(m_reg, pmax); alpha = __builtin_amdgcn_exp2f((m_reg - mn) * C); m_reg = mn; }
  float mnC = -mn * C;
#pragma unroll
  for (int r = 0; r < 16; ++r) p0[r] = fmaf(p0[r], C, mnC);
#pragma unroll
  for (int r = 0; r < 16; ++r) p1[r] = fmaf(p1[r], C, mnC);
#pragma unroll
  for (int r = 0; r < 16; ++r) p0[r] = __builtin_amdgcn_exp2f(p0[r]);
}
#define PK4(P, BASE, OUT) do { unsigned a0 = cvtpk(P[BASE + 0], P[BASE + 1]), a1 = cvtpk(P[BASE + 2], P[BASE + 3]);   \
    unsigned b0 = cvtpk(P[BASE + 4], P[BASE + 5]), b1 = cvtpk(P[BASE + 6], P[BASE + 7]);                              \
    auto r0 = __builtin_amdgcn_permlane32_swap(a0, b0, false, false); auto r1 = __builtin_amdgcn_permlane32_swap(a1, b1, false, false); \
    u32x4 w = {r0[0], r1[0], r0[1], r1[1]}; OUT = *reinterpret_cast<bf16x8*>(&w); } while (0)
__device__ __forceinline__ void finishSM(f32x16& p0, f32x16& p1, float alpha, float& l_reg, bf16x8& pa0, bf16x8& pa1, bf16x8& pa2, bf16x8& pa3) {
#pragma unroll
  for (int r = 0; r < 16; ++r) p1[r] = __builtin_amdgcn_exp2f(p1[r]);
  float ps = 0;
#pragma unroll
  for (int r = 0; r < 16; ++r) ps += p0[r];
#pragma unroll
  for (int r = 0; r < 16; ++r) ps += p1[r];
  { auto rr = __builtin_amdgcn_permlane32_swap(__float_as_uint(ps), __float_as_uint(ps), false, false);
    ps = __uint_as_float(rr[0]) + __uint_as_float(rr[1]); }
  l_reg = l_reg * alpha + ps;
  PK4(p0, 0, pa0); PK4(p0, 8, pa1); PK4(p1, 0, pa2); PK4(p1, 8, pa3);
}
__device__ __forceinline__ void packP(f32x16& p0, f32x16& p1, bf16x8& pa0, bf16x8& pa1, bf16x8& pa2, bf16x8& pa3) {
  PK4(p0, 0, pa0); PK4(p0, 8, pa1); PK4(p1, 0, pa2); PK4(p1, 8, pa3);
}
__device__ __forceinline__ void ret_decay(f32x16& p0, f32x16& p1, int iq, int j0, int hi, float lf2, float nlb2) {
#pragma unroll
  for (int r = 0; r < 16; ++r) {
    const float d0 = (float)(iq - (j0 + crow(r, hi)));
    const float d1 = d0 - 32.f;
    p0[r] *= __builtin_amdgcn_exp2f(d0 * (d0 >= 0.f ? lf2 : nlb2));
    p1[r] *= __builtin_amdgcn_exp2f(d1 * (d1 >= 0.f ? lf2 : nlb2));
  }
}
template <int DQK> __device__ __forceinline__ void qkt(f32x16& p0, f32x16& p1, const char* Ks, const bf16x8* qr, const char* qsave, int r32, int hi) {
#pragma unroll
  for (int r = 0; r < 16; ++r) { p0[r] = 0.f; p1[r] = 0.f; }
#pragma unroll
  for (int d0 = 0; d0 < DQK / 16; ++d0) { const int cb = (d0 * 16 + hi * 8) * 2;
    bf16x8 b0 = *reinterpret_cast<const bf16x8*>(Ks + kswz<DQK>(r32, cb));
    bf16x8 b1 = *reinterpret_cast<const bf16x8*>(Ks + kswz<DQK>(32 + r32, cb));
    p0 = __builtin_amdgcn_mfma_f32_32x32x16_bf16(b0, qr[d0], p0, 0, 0, 0);
    p1 = __builtin_amdgcn_mfma_f32_32x32x16_bf16(b1, qr[d0], p1, 0, 0, 0); }
}

constexpr int SHM_V = 64 * 128 * 2;
template <int MODE>
__device__ __forceinline__ void attn_item(const u16* __restrict__ Qp, int ldq, const u16* __restrict__ Kp, int ldk, const u16* __restrict__ Krp,
                                          const u16* __restrict__ Vp, int ldv, u16* __restrict__ Yp, int qpos0, float lf2, float nlb2, char* lds, bool dowrite = true, const float* __restrict__ cosm_ = nullptr, const float* __restrict__ sinm_ = nullptr,
                                          const u16* __restrict__ Pst = nullptr, int nblk = 0) {
  constexpr int DQK = MODE == 0 ? 192 : 128;
  constexpr int ND0 = DQK / 16;
  constexpr int SHM_K = 64 * (DQK * 2 + 16);
  const int tid = TID(), wid = tid >> 6, lane = tid & 63, r32 = lane & 31, hi = lane >> 5;
  char* V_lds = lds; char* K_lds = lds + 2 * SHM_V;
  float* wsp = (float*)(lds + 2 * SHM_V + 2 * SHM_K) + wid * 64; float* li_l = wsp; float* al_l = wsp + 32;
  float m_reg = -1e30f, l_reg = 0.f;
  f32x16 o[4];
#pragma unroll
  for (int d = 0; d < 4; ++d)
#pragma unroll
    for (int r = 0; r < 16; ++r) o[d][r] = 0.f;
  bf16x8 qr[ND0];
  const u16* Qw = Qp + (size_t)(wid * 32 + r32) * ldq + hi * 8;
  char* qsave = lds + 2 * SHM_V + 2 * SHM_K + 2048 + wid * 4096 + lane * 16;
#pragma unroll
  for (int d0 = 0; d0 < 8; ++d0) qr[d0] = *reinterpret_cast<const bf16x8*>(Qw + d0 * 16);
  if (MODE == 0) {
    bf16x8 f8 = *reinterpret_cast<const bf16x8*>(Qw + 128), f9 = *reinterpret_cast<const bf16x8*>(Qw + 144);
    bf16x8 f10 = *reinterpret_cast<const bf16x8*>(Qw + 160), f11 = *reinterpret_cast<const bf16x8*>(Qw + 176);
    const int spos = qpos0 + wid * 32 + r32;
    const float* cp = cosm_ + spos * 32 + hi * 8; const float* sp = sinm_ + spos * 32 + hi * 8;
    unsigned o8[4], o9[4], o10[4], o11[4];
    const f32x4 cA0 = *reinterpret_cast<const f32x4*>(cp), cA1 = *reinterpret_cast<const f32x4*>(cp + 4), cB0 = *reinterpret_cast<const f32x4*>(cp + 16), cB1 = *reinterpret_cast<const f32x4*>(cp + 20);
    const f32x4 sA0 = *reinterpret_cast<const f32x4*>(sp), sA1 = *reinterpret_cast<const f32x4*>(sp + 4), sB0 = *reinterpret_cast<const f32x4*>(sp + 16), sB1 = *reinterpret_cast<const f32x4*>(sp + 20);
#pragma unroll
    for (int jj = 0; jj < 4; ++jj) {
      float r8[2], r9[2], r10[2], r11[2];
#pragma unroll
      for (int e = 0; e < 2; ++e) { const int j = 2 * jj + e;
        const float c0 = j < 4 ? cA0[j & 3] : cA1[j & 3], s0 = j < 4 ? sA0[j & 3] : sA1[j & 3], c1 = j < 4 ? cB0[j & 3] : cB1[j & 3], s1 = j < 4 ? sB0[j & 3] : sB1[j & 3];
        const float x8 = bf2f((u16)f8[j]), x10 = bf2f((u16)f10[j]), x9 = bf2f((u16)f9[j]), x11 = bf2f((u16)f11[j]);
        r8[e] = x8 * c0 - x10 * s0; r10[e] = x10 * c0 + x8 * s0; r9[e] = x9 * c1 - x11 * s1; r11[e] = x11 * c1 + x9 * s1; }
      o8[jj] = cvtpk(r8[0], r8[1]); o9[jj] = cvtpk(r9[0], r9[1]); o10[jj] = cvtpk(r10[0], r10[1]); o11[jj] = cvtpk(r11[0], r11[1]);
    }
    { u32x4 w8 = {o8[0], o8[1], o8[2], o8[3]}, w9 = {o9[0], o9[1], o9[2], o9[3]}, w10 = {o10[0], o10[1], o10[2], o10[3]}, w11 = {o11[0], o11[1], o11[2], o11[3]};
      qr[ND0 - 4] = *reinterpret_cast<bf16x8*>(&w8); qr[ND0 - 3] = *reinterpret_cast<bf16x8*>(&w9); qr[ND0 - 2] = *reinterpret_cast<bf16x8*>(&w10); qr[ND0 - 1] = *reinterpret_cast<bf16x8*>(&w11); }
  }
  const int iq = qpos0 + wid * 32 + r32;
  const int sr = tid >> 4, sc = (tid & 15) * 8, vst0 = v_st(sr, sc), vst1 = v_st(32 + sr, sc);
  const int krr = tid >> 3, krc = (tid & 7) * 8;
  const int vb0 = (int)(uintptr_t)V_lds + v_rd_base(lane);
  bf16x8 vs0, vs1, ks0, ks1, kr0;
#define SLOAD(k0) do { vs0 = *reinterpret_cast<const bf16x8*>(Vp + (size_t)((k0) + sr) * ldv + sc); vs1 = *reinterpret_cast<const bf16x8*>(Vp + (size_t)((k0) + 32 + sr) * ldv + sc); \
    ks0 = *reinterpret_cast<const bf16x8*>(Kp + (size_t)((k0) + sr) * ldk + sc); ks1 = *reinterpret_cast<const bf16x8*>(Kp + (size_t)((k0) + 32 + sr) * ldk + sc); \
    if (MODE == 0) kr0 = *reinterpret_cast<const bf16x8*>(Krp + (size_t)((k0) + krr) * NU + krc); } while (0)
#define SWRITE(b) do { *reinterpret_cast<bf16x8*>(V_lds + (b) * SHM_V + vst0) = vs0; *reinterpret_cast<bf16x8*>(V_lds + (b) * SHM_V + vst1) = vs1; \
    *reinterpret_cast<bf16x8*>(K_lds + (b) * SHM_K + kswz<DQK>(sr, sc * 2)) = ks0; *reinterpret_cast<bf16x8*>(K_lds + (b) * SHM_K + kswz<DQK>(32 + sr, sc * 2)) = ks1; \
    if (MODE == 0) *reinterpret_cast<bf16x8*>(K_lds + (b) * SHM_K + kswz<DQK>(krr, (128 + krc) * 2)) = kr0; } while (0)
#define RESC(a) do { if (MODE == 0) { if (__any((a) < 1.f)) { if (hi == 0) al_l[r32] = (a); asm volatile("s_waitcnt lgkmcnt(0)" ::: "memory"); \
    _Pragma("unroll") for (int d = 0; d < 4; ++d) _Pragma("unroll") for (int r = 0; r < 16; ++r) o[d][r] *= al_l[crow(r, hi)]; } } } while (0)
#define PART(P0, P1, MN, AL, J0) do { if (MODE == 0) partialSM(P0, P1, m_reg, MN, AL); else ret_decay(P0, P1, iq, (J0) + qpos0, hi, lf2, nlb2); } while (0)
#define FIN(P0, P1, AL) do { if (MODE == 0) finishSM(P0, P1, AL, l_reg, pa0, pa1, pa2, pa3); else packP(P0, P1, pa0, pa1, pa2, pa3); } while (0)
  f32x16 pA0, pA1, pB0, pB1; float mnA = 0.f, mnB = 0.f, alA = 1.f, alB = 1.f; bf16x8 pa0, pa1, pa2, pa3;
  constexpr int NT = MODE == 0 ? SEQ / 64 : 4;
  if (MODE == 1) {
    const float lb2 = -nlb2;
    {
      const int sr4 = tid >> 4, sc4 = (tid & 15) * 8;
#pragma unroll
      for (int dir = 0; dir < 2; ++dir) {
        float accs[4][8];
#pragma unroll
        for (int q = 0; q < 4; ++q)
#pragma unroll
          for (int e = 0; e < 8; ++e) accs[q][e] = 0.f;
#pragma unroll
        for (int mb = 0; mb < 8; mb += 4) {
          const bool any = dir == 0 ? (mb < nblk) : (mb + 3 > nblk);
          if (any) {
            u32x4 x[4][4];
#pragma unroll
            for (int mi = 0; mi < 4; ++mi) {
              const u16* Pm = Pst + (size_t)((mb + mi) * 2 + dir) * 16384 + sc4;
#pragma unroll
              for (int q = 0; q < 4; ++q) x[mi][q] = *reinterpret_cast<const u32x4*>(Pm + (sr4 + 32 * q) * 128);
            }
#pragma unroll
            for (int mi = 0; mi < 4; ++mi) {
              const int m = mb + mi;
              const bool in = dir == 0 ? (m < nblk) : (m > nblk);
              const float wgt = in ? __builtin_amdgcn_exp2f((dir == 0 ? lf2 * (float)(nblk - 1 - m) : lb2 * (float)(m - nblk - 1)) * 256.f) : 0.f;
#pragma unroll
              for (int q = 0; q < 4; ++q)
#pragma unroll
                for (int e = 0; e < 4; ++e) { accs[q][2 * e] = fmaf(wgt, bflo(x[mi][q][e]), accs[q][2 * e]); accs[q][2 * e + 1] = fmaf(wgt, bfhi(x[mi][q][e]), accs[q][2 * e + 1]); }
            }
          }
        }
#pragma unroll
        for (int q = 0; q < 4; ++q) {
          const int row = sr4 + 32 * q;
          u32x4 w; w[0] = cvtpk(accs[q][0], accs[q][1]); w[1] = cvtpk(accs[q][2], accs[q][3]); w[2] = cvtpk(accs[q][4], accs[q][5]); w[3] = cvtpk(accs[q][6], accs[q][7]);
          *reinterpret_cast<u32x4*>(lds + dir * 32768 + (row >> 6) * 16384 + v_st(row & 63, sc4)) = w;
        }
      }
    }
    __syncthreads();
    const float rowpos = (float)(wid * 32 + r32);
#pragma unroll
    for (int dir = 0; dir < 2; ++dir) {
      const float rf = __builtin_amdgcn_exp2f(dir == 0 ? lf2 * rowpos : lb2 * (256.f - rowpos));
      bf16x8 qs[8];
#pragma unroll
      for (int k = 0; k < 8; ++k) {
        u32x4 w;
#pragma unroll
        for (int e = 0; e < 4; ++e) w[e] = cvtpk(bf2f((u16)qr[k][2 * e]) * rf, bf2f((u16)qr[k][2 * e + 1]) * rf);
        qs[k] = *reinterpret_cast<bf16x8*>(&w);
      }
      const int vbs = (int)(uintptr_t)(lds + dir * 32768) + v_rd_base(lane);
      pv_d0(o, vbs, qs[0], qs[1], qs[2], qs[3]);
      pv_d0(o, vbs + 16384, qs[4], qs[5], qs[6], qs[7]);
    }
    __syncthreads();
  }
  SLOAD(0); SWRITE(0); __syncthreads();
  qkt<DQK>(pA0, pA1, K_lds, qr, qsave, r32, hi); PART(pA0, pA1, mnA, alA, 0);
  SLOAD(64); SWRITE(1); __syncthreads();
  for (int j = 1; j + 1 < NT; j += 2) {
    SBAR(); qkt<DQK>(pB0, pB1, K_lds + SHM_K, qr, qsave, r32, hi);
    FIN(pA0, pA1, alA); SBAR();
    SLOAD((j + 1) * 64); SBAR();
    pv_d0(o, vb0, pa0, pa1, pa2, pa3); PART(pB0, pB1, mnB, alB, j * 64);
    __syncthreads(); SWRITE(0);
    RESC(alB); __syncthreads();
    SBAR(); qkt<DQK>(pA0, pA1, K_lds, qr, qsave, r32, hi);
    FIN(pB0, pB1, alB); SBAR();
    SLOAD((j + 2) * 64); SBAR();
    pv_d0(o, vb0 + SHM_V, pa0, pa1, pa2, pa3); PART(pA0, pA1, mnA, alA, (j + 1) * 64);
    __syncthreads(); SWRITE(1);
    RESC(alA); __syncthreads();
  }
  SBAR(); qkt<DQK>(pB0, pB1, K_lds + SHM_K, qr, qsave, r32, hi);
  FIN(pA0, pA1, alA); SBAR();
  pv_d0(o, vb0, pa0, pa1, pa2, pa3); PART(pB0, pB1, mnB, alB, (NT - 1) * 64);
  __syncthreads(); RESC(alB);
  FIN(pB0, pB1, alB); SBAR();
  pv_d0(o, vb0 + SHM_V, pa0, pa1, pa2, pa3);
  u16* Yw = Yp + (size_t)(wid * 32) * 2048;
  if (MODE == 0) {
    if (hi == 0) li_l[r32] = l_reg;
    asm volatile("s_waitcnt lgkmcnt(0)" ::: "memory");
#pragma unroll
    for (int r = 0; r < 16; ++r) {
      const float rli = __builtin_amdgcn_rcpf(li_l[crow(r, hi)]);
#pragma unroll
      for (int d = 0; d < 4; ++d) o[d][r] *= rli;
    }
  } else {
#pragma unroll
    for (int r = 0; r < 16; ++r) {
      float s = o[0][r] + o[1][r] + o[2][r] + o[3][r];
#pragma unroll
      for (int m = 16; m >= 1; m >>= 1) s += __shfl_xor(s, m);
      const float mu = s * (1.f / 128.f);
      float dv = 0.f;
#pragma unroll
      for (int d = 0; d < 4; ++d) { const float t = o[d][r] - mu; dv += t * t; }
#pragma unroll
      for (int m = 16; m >= 1; m >>= 1) dv += __shfl_xor(dv, m);
      const float rstd = rsqrtf(dv * (1.f / 128.f) + EPS);
#pragma unroll
      for (int d = 0; d < 4; ++d) o[d][r] = (o[d][r] - mu) * rstd;
    }
  }
  __syncthreads();
  {
    float* ot = reinterpret_cast<float*>(lds + wid * 16384);
#pragma unroll
    for (int r = 0; r < 16; ++r) {
      const int orow = crow(r, hi);
#pragma unroll
      for (int d = 0; d < 4; ++d) ot[orow * 128 + ((d * 32 + r32 + 4 * orow) & 127)] = o[d][r];
    }
    asm volatile("s_waitcnt lgkmcnt(0)" ::: "memory");
    const int erow = lane >> 1, ecol = (lane & 1) * 64;
    u16* yp = Yw + (size_t)erow * 2048 + ecol;
    u32x4 gt[8];
#pragma unroll
    for (int i = 0; i < 8; ++i) gt[i] = *reinterpret_cast<const u32x4*>(yp + 8 * i);
#pragma unroll
    for (int i = 0; i < 8; ++i) {
      const f32x4 a = *reinterpret_cast<const f32x4*>(ot + erow * 128 + ((ecol + 8 * i + 4 * erow) & 127));
      const f32x4 b = *reinterpret_cast<const f32x4*>(ot + erow * 128 + ((ecol + 8 * i + 4 + 4 * erow) & 127));
      u32x4 w;
      w[0] = cvtpk(a[0] * bflo(gt[i][0]), a[1] * bfhi(gt[i][0])); w[1] = cvtpk(a[2] * bflo(gt[i][1]), a[3] * bfhi(gt[i][1]));
      w[2] = cvtpk(b[0] * bflo(gt[i][2]), b[1] * bfhi(gt[i][2])); w[3] = cvtpk(b[2] * bflo(gt[i][3]), b[3] * bfhi(gt[i][3]));
      if (dowrite) *reinterpret_cast<u32x4*>(yp + 8 * i) = w;
    }
  }
  __syncthreads();
#undef SLOAD
#undef SWRITE
#undef RESC
#undef PART
#undef FIN
}

__device__ void ret_pbuild(const u16* __restrict__ U, u16* __restrict__ Pout, const float* __restrict__ cosr, const float* __restrict__ sinr, int tok0, int hh, int m, int dir, float lg2v, char* lds) {
  const int tid = TID(), wid = tid >> 6, lane = tid & 63, r32 = lane & 31, hi = lane >> 5;
  char* Ks = lds; char* Vs = lds + 16384;
  const int a = wid >> 1, b0 = (wid & 1) * 2;
  const int kb = (int)(uintptr_t)Ks + v_rd_base(lane) + a * 512;
  const int vb = (int)(uintptr_t)Vs + v_rd_base(lane) + b0 * 512;
  f32x16 acc0, acc1;
#pragma unroll
  for (int r = 0; r < 16; ++r) { acc0[r] = 0.f; acc1[r] = 0.f; }
  const float g64 = __builtin_amdgcn_exp2f(lg2v * 64.f);
  const int krow = tid >> 3, kc = (tid & 7) * 8;
  const int sr = tid >> 4, sc = (tid & 15) * 8;
  const float pre = 0.08838834764831845f * __builtin_amdgcn_exp2f(dir == 0 ? -lg2v * (float)krow : lg2v * (float)krow);
  for (int tt = 0; tt < 4; ++tt) {
    const int t = dir == 0 ? tt : 3 - tt;
    const int key0 = m * 256 + t * 64;
    const u16* kp = U + (size_t)(tok0 + key0 + krow) * NU + 1536 + hh * 128 + kc;
    const u32x4 x1 = *reinterpret_cast<const u32x4*>(kp), x2 = *reinterpret_cast<const u32x4*>(kp + 64);
    const u16* vp = U + (size_t)(tok0 + key0 + sr) * NU + 2048 + hh * 128 + sc;
    const bf16x8 v0 = *reinterpret_cast<const bf16x8*>(vp), v1 = *reinterpret_cast<const bf16x8*>(vp + (size_t)32 * NU);
    const float* cp = cosr + (key0 + krow) * 64 + kc; const float* sp = sinr + (key0 + krow) * 64 + kc;
    const f32x4 c0 = *reinterpret_cast<const f32x4*>(cp), c1 = *reinterpret_cast<const f32x4*>(cp + 4);
    const f32x4 s0 = *reinterpret_cast<const f32x4*>(sp), s1 = *reinterpret_cast<const f32x4*>(sp + 4);
    u32x4 w1, w2;
#pragma unroll
    for (int e = 0; e < 4; ++e) {
      const float ca = e < 2 ? c0[2 * e] : c1[2 * e - 4], cb = e < 2 ? c0[2 * e + 1] : c1[2 * e - 3];
      const float sa = e < 2 ? s0[2 * e] : s1[2 * e - 4], sb = e < 2 ? s0[2 * e + 1] : s1[2 * e - 3];
      const float xa = bflo(x1[e]), xb = bfhi(x1[e]), ya = bflo(x2[e]), yb = bfhi(x2[e]);
      w1[e] = cvtpk((xa * ca - ya * sa) * pre, (xb * cb - yb * sb) * pre);
      w2[e] = cvtpk((ya * ca + xa * sa) * pre, (yb * cb + xb * sb) * pre);
    }
    *reinterpret_cast<u32x4*>(Ks + v_st(krow, kc)) = w1; *reinterpret_cast<u32x4*>(Ks + v_st(krow, 64 + kc)) = w2;
    *reinterpret_cast<bf16x8*>(Vs + v_st(sr, sc)) = v0; *reinterpret_cast<bf16x8*>(Vs + v_st(32 + sr, sc)) = v1;
    __syncthreads();
    if (tt > 0) {
#pragma unroll
      for (int r = 0; r < 16; ++r) { acc0[r] *= g64; acc1[r] *= g64; }
    }
#define PK(L, H) (bf16x8){L[0], L[1], L[2], L[3], H[0], H[1], H[2], H[3]}
#define PB_STEP(KS) do { \
      const s16x4 al = tr_read<v_rd_off(0, KS, 0)>(kb), ah = tr_read<v_rd_off(0, KS, 1)>(kb); \
      const s16x4 bl0 = tr_read<v_rd_off(0, KS, 0)>(vb), bh0 = tr_read<v_rd_off(0, KS, 1)>(vb); \
      const s16x4 bl1 = tr_read<v_rd_off(1, KS, 0)>(vb), bh1 = tr_read<v_rd_off(1, KS, 1)>(vb); \
      asm volatile("s_waitcnt lgkmcnt(0)" ::: "memory"); SBAR(); \
      acc0 = __builtin_amdgcn_mfma_f32_32x32x16_bf16(PK(al, ah), PK(bl0, bh0), acc0, 0, 0, 0); \
      acc1 = __builtin_amdgcn_mfma_f32_32x32x16_bf16(PK(al, ah), PK(bl1, bh1), acc1, 0, 0, 0); } while (0)
    PB_STEP(0); PB_STEP(1); PB_STEP(2); PB_STEP(3);
#undef PB_STEP
#undef PK
    __syncthreads();
  }
  if (dir == 0) {
#pragma unroll
    for (int r = 0; r < 16; ++r) { acc0[r] *= g64; acc1[r] *= g64; }
  }
#pragma unroll
  for (int r = 0; r < 16; ++r) {
    u16* pp = Pout + (size_t)(32 * a + crow(r, hi)) * 128 + 32 * b0 + r32;
    pp[0] = f2bf(acc0[r]); pp[32] = f2bf(acc1[r]);
  }
}

#define XB_TMO      128
#define XB_XCNT(j)  (256  + 64 * (j))
#define XB_XSUB(j)  (1280 + 64 * (j))
#define XB_XGEN(j)  (2304 + 64 * (j))
#define XB_TOP      3328
#define XB_TOPGEN   3392
#define XCD_BAR_WORDS 3456
#define XB_SPIN_CAP (1u << 18)
__device__ __forceinline__ unsigned xb_ld(unsigned* p)              { return __hip_atomic_load(p, __ATOMIC_RELAXED, __HIP_MEMORY_SCOPE_AGENT); }
__device__ __forceinline__ unsigned xb_add(unsigned* p, unsigned v) { return __hip_atomic_fetch_add(p, v, __ATOMIC_RELAXED, __HIP_MEMORY_SCOPE_AGENT); }
__device__ __forceinline__ unsigned xb_xcc_id() { return (unsigned)__builtin_amdgcn_s_getreg((3 << 11) | 20) & 0xFu; }
#define XB_SPIN(cond, bar) do { unsigned _sp = 0; while (cond) { __builtin_amdgcn_s_sleep(1); \
    if ((++_sp & 255u) == 0u) { if (xb_ld(&(bar)[XB_TMO])) break; if (_sp > XB_SPIN_CAP) { atomicAdd(&(bar)[XB_TMO], 1u); break; } } } } while (0)
struct XcdBarrier { unsigned* bar; unsigned x; volatile LAS unsigned* st; };
__device__ __forceinline__ XcdBarrier xcd_barrier_post(unsigned* bar, volatile LAS unsigned* st) {
  XcdBarrier b; b.bar = bar; b.x = xb_xcc_id(); b.st = st;
  if (threadIdx.x == 0) (void)xb_add(&bar[XB_XCNT(b.x)], 1u);
  return b;
}
__device__ __forceinline__ void xcd_barrier_complete(unsigned* bar, unsigned x, unsigned& nloc, unsigned& nx) {
  const unsigned G = gridDim.x * gridDim.y * gridDim.z;
  unsigned sum, cnt, mine, sp = 0u;
  for (;;) {
    sum = 0u; cnt = 0u; mine = 0u;
#pragma unroll
    for (unsigned j = 0; j < 16; ++j) { const unsigned c = xb_ld(&bar[XB_XCNT(j)]); sum += c; cnt += (c > 0u) ? 1u : 0u; mine = (j == x) ? c : mine; }
    if (sum == G) break;
    __builtin_amdgcn_s_sleep(1);
    if ((++sp & 255u) == 0u) { if (xb_ld(&bar[XB_TMO])) break; if (sp > XB_SPIN_CAP) { atomicAdd(&bar[XB_TMO], 1u); break; } }
  }
  nloc = mine > 0u ? mine : 1u; nx = cnt > 0u ? cnt : 1u;
}
__device__ __forceinline__ void xcd_barrier(const XcdBarrier& b) {
  asm volatile("s_waitcnt vmcnt(0)" ::: "memory");
  __syncthreads();
  if (threadIdx.x == 0) {
    unsigned* bar = b.bar;
    __builtin_amdgcn_s_waitcnt(0);
    unsigned nloc = b.st[0], nx = b.st[1];
    if (nloc == 0u) { xcd_barrier_complete(bar, b.x, nloc, nx); b.st[0] = nloc; b.st[1] = nx; }
    const unsigned old = xb_add(&bar[XB_XSUB(b.x)], 1u);
    const unsigned gen = old / nloc;
    if (old + 1u == (gen + 1u) * nloc) {
      __builtin_amdgcn_fence(__ATOMIC_RELEASE, "agent");
      asm volatile("s_waitcnt vmcnt(0)" ::: "memory");
      const unsigned og = xb_add(&bar[XB_TOP], 1u);
      const unsigned tg = og / nx;
      if (og + 1u == (tg + 1u) * nx) xb_add(&bar[XB_TOPGEN], 1u);
      else XB_SPIN(xb_ld(&bar[XB_TOPGEN]) == tg, bar);
      __builtin_amdgcn_fence(__ATOMIC_ACQUIRE, "agent");
      xb_add(&bar[XB_XGEN(b.x)], 1u);
      asm volatile("s_waitcnt vmcnt(0)" ::: "memory");
    } else {
      XB_SPIN(xb_ld(&bar[XB_XGEN(b.x)]) == gen, bar);
      __builtin_amdgcn_fence(__ATOMIC_ACQUIRE, "agent");
      asm volatile("s_waitcnt vmcnt(0)" ::: "memory");
    }
  }
  __syncthreads();
}

constexpr int N_PHASES = 22;

__device__ void run_phase(const Params& p, int ph, char* lds, const XcdBarrier& xb) {
  char* ws = p.ws;
  u16* XN = (u16*)(ws + OFF_XN); u16* U = (u16*)(ws + OFF_U); u16* Y = (u16*)(ws + OFF_Y); u16* Q = (u16*)(ws + OFF_Q); u16* KV = (u16*)(ws + OFF_KV);
  const float* cosr = (const float*)(ws + OFF_COSR); const float* sinr = (const float*)(ws + OFF_SINR);
  const float* cosm = (const float*)(ws + OFF_COSM); const float* sinm = (const float*)(ws + OFF_SINM);
  if (ph == N_PHASES - 1) { phase_final(p.out, p.in[13]); return; }
  const int bid_ = BID(); const int xcd = bid_ & 7, slot = bid_ >> 3, nslots = gridDim.x >> 3;
  const int lh = (ph - 1) / 5, sub = (ph - 1) % 5, l = lh >> 1, h = lh & 1;
  const size_t xoff = (size_t)h * MH * DM;
  const float* xin = (l == 0 ? p.in[0] : (const float*)p.out) + xoff;
  u16* Yh = Y + (size_t)h * MH * 2048;
  float* SSQ = (float*)(ws + OFF_SSQ);
  const bool fuse_ok = MK_COOP && nslots == 32;
  const u16* XNh = XN + (size_t)h * MH * DM;
  if (sub == 0) {
    if (h == 0) { for (int i = bid_ * NTHR + TID(); i < 6 * MH; i += gridDim.x * NTHR) SSQ[i] = 0.f; }
    if (lh != 0 && h == 0) { for (int rep = 0; rep < REP_NORM; ++rep) phase_norm(xin, XN, bid_, gridDim.x); }
  } else if (sub == 1) {
    if (fuse_ok && l == 1 && h == 0) { for (int i = bid_ * NTHR + TID(); i < 2 * MH; i += gridDim.x * NTHR) SSQ[4 * MH + i] = 0.f; }
    EpiArgs ea{}; ea.c0 = U; ea.c1 = Yh; ea.ssq_q = SSQ + (size_t)h * 2 * MH; ea.ssq_kv = SSQ + (size_t)h * 2 * MH + MH;
    const u16* Bt = (const u16*)(ws + OFF_WIN) + (size_t)l * NINP * 1024;
    for (int rep = 0; rep < REP_B; ++rep)
      gemm256_tiles<EPI2_IN, true>(XNh, 1024, Bt, 1024, slot, 4 * 16, nslots, xcd, 2, lds, ea);
  } else if (sub == 2) {
    for (int rep = 0; rep < REP_ROPE; ++rep)
    rope_rows(U, (u16*)(ws + OFF_K3), (const float*)(ws + OFF_LG2) + l * 8, cosr, sinr, cosm, sinm, rep == REP_ROPE - 1);
    {
      EpiArgs ea{}; ea.c0 = U; ea.c1 = Yh; ea.ssq_q = SSQ + (size_t)h * 2 * MH; ea.ssq_kv = SSQ + (size_t)h * 2 * MH + MH;
      const u16* Bt = (const u16*)(ws + OFF_WIN) + (size_t)l * NINP * 1024;
      gemm256_tiles<EPI2_IN, true>(XNh, 1024, Bt, 1024, 64 + slot, 4 * 21, nslots, xcd, 2, lds, ea);
    }
    for (int rep = 0; rep < REP_PB; ++rep)
    for (int tk = slot; tk < 32; tk += nslots) {
      const int pr = xcd * 2 + (tk >> 4), m = (tk >> 1) & 7, dir = tk & 1;
      const float lg = ((const float*)(ws + OFF_LG2))[l * 8 + dir * 4 + (pr & 3)];
      ret_pbuild(U, (u16*)(ws + OFF_PST) + (size_t)((pr * 8 + m) * 2 + dir) * 16384, cosr, sinr, (pr >> 2) * SEQ, pr & 3, m, dir, lg, lds);
    }
    {
      EpiArgs ea{}; ea.c0 = Q; ea.ssq_q = SSQ + (size_t)h * 2 * MH;
      const u16* Bt = (const u16*)(ws + OFF_WUQ) + (size_t)l * 1536 * 384;
      for (int rep = 0; rep < REP_UP; ++rep)
        if (nslots == 32) { if (slot >= 20) gemm256_tiles<EPI2_Q>(U + 2560, NU, Bt, 384, slot - 20, 4 * 6, 12, xcd, 2, lds, ea); }
        else gemm256_tiles<EPI2_Q>(U + 2560, NU, Bt, 384, slot, 4 * 6, nslots, xcd, 2, lds, ea);
    }
    {
      EpiArgs ea{}; ea.c0 = KV; ea.ssq_kv = SSQ + (size_t)h * 2 * MH + MH;
      const u16* Bt = (const u16*)(ws + OFF_WUKV) + (size_t)l * 2048 * 256;
      for (int rep = 0; rep < REP_UP; ++rep)
        gemm256_tiles<EPI2_KV>(U + 2944, NU, Bt, 256, slot, 4 * 8, nslots, xcd, 2, lds, ea);
    }
  } else if (sub == 3) {
    for (int j = slot; j < 32 + 16; j += nslots) {
      if (j < 32) {
        const int it = (xcd * 4 + (j >> 3)) * 8 + (j & 7);
        const int qb = it & 7, hh = (it >> 3) & 7, b = it >> 6;
        const size_t tok0 = (size_t)b * SEQ, i0 = tok0 + qb * 256;
        for (int rep = 0; rep < REP_MLA; ++rep)
        attn_item<0>(Q + i0 * 1536 + hh * 192, 1536, KV + tok0 * 2048 + hh * 256, 2048, U + tok0 * NU + 3200,
                     KV + tok0 * 2048 + hh * 256 + 128, 2048, Yh + i0 * 2048 + 1024 + hh * 128, qb * 256, 0.f, 0.f, lds, rep == REP_MLA - 1, cosm, sinm);
      } else {
        const int r = (xcd * 2 + ((j - 32) >> 3)) * 8 + (j & 7);
        const int qb = r & 7, hh = (r >> 3) & 3, b = r >> 5;
        const size_t tok0 = (size_t)b * SEQ, i0 = tok0 + qb * 256;
        const float* dl = (const float*)(ws + OFF_LG2) + l * 8;
        const float lf2 = dl[hh], lb2 = dl[4 + hh];
        for (int rep = 0; rep < REP_RET; ++rep)
        attn_item<1>(U + i0 * NU + 1024 + hh * 128, NU, (const u16*)(ws + OFF_K3) + i0 * 512 + hh * 128, 512, nullptr,
                     U + i0 * NU + 2048 + hh * 128, NU, Yh + i0 * 2048 + 512 + hh * 128, qb * 256, lf2, -lb2, lds, rep == REP_RET - 1, nullptr, nullptr,
                     (const u16*)(ws + OFF_PST) + (size_t)(r >> 3) * 8 * 2 * 16384, qb);
      }
    }
    {
      const bool split = (nslots == 32);
      const int ib = split ? xcd * 16 + (slot - 16) : bid_, nib = split ? 128 : (int)gridDim.x;
      if (!split || slot >= 16) {
        for (int rep = 0; rep < REP_CONV; ++rep)
        for (int t = ib; t < MH / 32; t += nib)
          conv_tile(U, Yh, p.in[3] + (size_t)l * 31 * 512, p.in[4] + l * 512, p.in[5] + l * 512, p.in[6] + l * 512, t * 32, lds, rep == REP_CONV - 1);
        if (h == 0 && !(fuse_ok && l == 1)) {
          const float* xnext = (l == 0 ? p.in[0] : (const float*)p.out) + (size_t)MH * DM;
          for (int rep = 0; rep < REP_NORM; ++rep) phase_norm(xnext, XN + (size_t)MH * DM, ib, nib, 0, split ? 5376 : MH);
        }
      }
      if (split && slot < 16 && h == 0 && !(fuse_ok && l == 1)) {
        const float* xnext = (l == 0 ? p.in[0] : (const float*)p.out) + (size_t)MH * DM;
        for (int rep = 0; rep < REP_NORM; ++rep) phase_norm(xnext, XN + (size_t)MH * DM, xcd * 16 + slot, 128, 5376, MH);
      }
    }
  } else {
    if (h == 1) {
      EpiArgs ea{}; ea.resid = (l == 0 ? p.in[0] : (const float*)p.out); ea.xout = p.out;
      ea.fuse = fuse_ok ? 1 : 0; ea.xb = &xb; ea.ssqf = (float*)(ws + OFF_SSQF); ea.fg = p.in[13]; ea.xn_out = (l == 0 ? XN : nullptr);
      if (fuse_ok && l == 0) { for (int i = bid_ * NTHR + TID(); i < 4 * MH; i += gridDim.x * NTHR) SSQ[i] = 0.f; }
      const u16* Bt = (const u16*)(ws + OFF_WOUT) + (size_t)l * 1024 * 2048;
      for (int rep = 0; rep < (l == 0 ? REP_E0 : 1); ++rep)
        if (ea.fuse) gemm256_tiles<EPI2_OUTF>(Y, 2048, Bt, 2048, slot, 8 * 4, nslots, xcd, 3, lds, ea);
        else gemm256_tiles<EPI2_OUT>(Y, 2048, Bt, 2048, slot, 8 * 4, nslots, xcd, 3, lds, ea);
    }
  }
}
__device__ __forceinline__ bool phase_empty(int ph) {
  if (ph == 1) return true;
  if (MK_COOP && (gridDim.x >> 3) == 32 && ph == 11) return true;
  if (ph >= 1 && ph < N_PHASES - 1) { const int lh = (ph - 1) / 5, sub = (ph - 1) % 5; if (sub == 4 && (lh & 1) == 0) return true; if (sub == 0 && (lh & 1) == 1) return true; }
  return false;
}

__global__ void __launch_bounds__(NTHR) mega_kernel(Params p, int ph_lo, int ph_hi) {
  extern __shared__ __attribute__((aligned(16))) char lds[];
  __shared__ uint4 xb_words;
  if (threadIdx.x == 0) xb_words = make_uint4(0u, 0u, 0u, 0u);
  __syncthreads();
  XcdBarrier xb = xcd_barrier_post((unsigned*)(p.ws + OFF_BAR), (volatile LAS unsigned*)&xb_words);
  int ph = ph_lo;
  if (ph == 0) {
    for (int rep = 0; rep < REP_PREP; ++rep) phase_prep(p, lds);
    for (int rep = 0; rep < REP_NORM; ++rep) phase_norm2(p.in[0], (u16*)(p.ws + OFF_XN), BID(), gridDim.x);
    for (int i = BID() * NTHR + TID(); i < 6 * MH; i += gridDim.x * NTHR) ((float*)(p.ws + OFF_SSQ))[i] = 0.f;
    ph = 1;
    if (ph_hi > 1000000) cg::this_grid().sync();
    if (ph < ph_hi) xcd_barrier(xb);
  }
  const int ph_end = (MK_COOP && (gridDim.x >> 3) == 32 && ph_hi == N_PHASES) ? N_PHASES - 1 : ph_hi;
  for (; ph < ph_end; ++ph) {
    if (phase_empty(ph)) continue;
    run_phase(p, ph, lds, xb);
    if (ph + 1 < ph_end) { for (int rep = 0; rep < REP_SYNC; ++rep) xcd_barrier(xb); }
  }
}

extern "C" void kernel_launch(void* const* d_in, const int* in_sizes, int n_in, void* d_out, int out_size, void* d_ws, size_t ws_size, hipStream_t stream) {
  static int grid = 0;
  if (grid == 0) {
    if (n_in != 14 || ws_size < WS_END) { fprintf(stderr, "kernel_launch: bad setup n_in %d ws %zu need %zu\n", n_in, ws_size, (size_t)WS_END); return; }
    int dev = 0, cus = 0, per_cu = 0;
    hipGetDevice(&dev);
    hipDeviceGetAttribute(&cus, hipDeviceAttributeMultiprocessorCount, dev);
    if (hipFuncSetAttribute((const void*)mega_kernel, hipFuncAttributeMaxDynamicSharedMemorySize, LDS_BYTES) != hipSuccess) { fprintf(stderr, "hipFuncSetAttribute failed\n"); return; }
    hipOccupancyMaxActiveBlocksPerMultiprocessor(&per_cu, (const void*)mega_kernel, NTHR, LDS_BYTES);
    if (per_cu < 1) { fprintf(stderr, "occupancy query says %d\n", per_cu); (void)hipGetLastError(); per_cu = 1; }
    grid = (cus / 8) * 8;
  }
  Params p{};
  for (int i = 0; i < 14; ++i) p.in[i] = (const float*)d_in[i];
  p.out = (float*)d_out; p.ws = (char*)d_ws;
#if MK_COOP
  hipMemsetAsync((char*)d_ws + OFF_BAR, 0, XCD_BAR_WORDS * 4, stream);
  int lo = 0, hi = N_PHASES;
  void* args[] = {&p, &lo, &hi};
  hipError_t e = hipLaunchCooperativeKernel((const void*)mega_kernel, dim3(grid), dim3(NTHR), args, LDS_BYTES, stream);
  if (e != hipSuccess) fprintf(stderr, "cooperative launch failed: %s (grid %d)\n", hipGetErrorString(e), grid);
#else
  for (int ph = 0; ph < N_PHASES; ++ph) {
    if (ph == 1 || ph == 5 || ph == 15 || ph == 6 || ph == 16) continue;
    hipLaunchKernelGGL(mega_kernel, dim3(grid), dim3(NTHR), LDS_BYTES, stream, p, ph, ph + 1);
  }
#endif
}
```

```cpp
#include <hip/hip_runtime.h>
#include <hip/hip_bf16.h>
#include <hip/hip_cooperative_groups.h>
#include <cstdio>
#include <cstdint>
namespace cg = cooperative_groups;

#ifndef REP_B
#define REP_B 1
#endif
#ifndef REP_UP
#define REP_UP 1
#endif
#ifndef REP_MLA
#define REP_MLA 1
#endif
#ifndef REP_RET
#define REP_RET 1
#endif
#ifndef REP_SYNC
#define REP_SYNC 1
#endif
#ifndef REP_CONV
#define REP_CONV 1
#endif
#ifndef REP_ROPE
#define REP_ROPE 1
#endif
#ifndef REP_PREP
#define REP_PREP 1
#endif
#ifndef REP_NORM
#define REP_NORM 1
#endif
#ifndef REP_PB
#define REP_PB 1
#endif
#ifndef REP_E0
#define REP_E0 1
#endif
#ifndef MK_COOP
#define MK_COOP 1
#endif

typedef unsigned short u16;
using bf16x8 = __attribute__((ext_vector_type(8))) short;
using s16x4  = __attribute__((ext_vector_type(4))) short;
using f32x16 = __attribute__((ext_vector_type(16))) float;
using f32x4  = __attribute__((ext_vector_type(4))) float;
using u32x4  = __attribute__((ext_vector_type(4))) unsigned;
using u32x2  = __attribute__((ext_vector_type(2))) unsigned;

constexpr int NTHR = 512;
constexpr int SEQ = 2048, DM = 1024, NIN = 5312;
constexpr int MH = 8192;
constexpr int NU = 3328;
constexpr int NINP = 5376;
constexpr int NYT = 26;
constexpr int NYT2 = 13;
constexpr float EPS = 1e-6f;

constexpr size_t OFF_WIN  = 0;
constexpr size_t OFF_WUQ  = OFF_WIN  + (size_t)2 * NINP * 1024 * 2;
constexpr size_t OFF_WUKV = OFF_WUQ  + (size_t)2 * 1536 * 384 * 2;
constexpr size_t OFF_WOUT = OFF_WUKV + (size_t)2 * 2048 * 256 * 2;
constexpr size_t OFF_COSR = OFF_WOUT + (size_t)2 * 1024 * 2048 * 2;
constexpr size_t OFF_SINR = OFF_COSR + (size_t)2048 * 64 * 4;
constexpr size_t OFF_COSM = OFF_SINR + (size_t)2048 * 64 * 4;
constexpr size_t OFF_SINM = OFF_COSM + (size_t)2048 * 32 * 4;
constexpr size_t OFF_XN   = OFF_SINM + (size_t)2048 * 32 * 4;
constexpr size_t OFF_U    = OFF_XN   + (size_t)2 * MH * 1024 * 2;
constexpr size_t OFF_Y    = OFF_U    + (size_t)MH * NU * 2;
constexpr size_t OFF_Q    = OFF_Y    + (size_t)2 * MH * 2048 * 2;
constexpr size_t OFF_KV   = OFF_Q    + (size_t)MH * 1536 * 2;
constexpr size_t OFF_BAR  = OFF_KV   + (size_t)MH * 2048 * 2;
constexpr size_t OFF_LG2  = OFF_BAR  + 16384;
constexpr size_t OFF_K3   = OFF_LG2  + 256;
constexpr size_t K3_IMG   = (size_t)MH * 512;
constexpr size_t OFF_PST  = OFF_K3   + K3_IMG * 2;
constexpr size_t OFF_SSQ  = OFF_PST  + (size_t)16 * 8 * 2 * 16384 * 2;
constexpr size_t OFF_SSQF = OFF_SSQ  + (size_t)4 * MH * 4;
constexpr size_t WS_END   = OFF_SSQF + (size_t)2 * MH * 4;

constexpr int LDS_BYTES = 131072;

struct Params {
  const float* in[14];
  float* out;
  char* ws;
};

__device__ __forceinline__ unsigned cvtpk(float lo, float hi) {
  unsigned r; asm volatile("v_cvt_pk_bf16_f32 %0, %1, %2" : "=v"(r) : "v"(lo), "v"(hi)); return r;
}
__device__ __forceinline__ float bf2f(u16 v) { return __uint_as_float(((unsigned)v) << 16); }
__device__ __forceinline__ float bflo(unsigned w) { return __uint_as_float(w << 16); }
__device__ __forceinline__ float bfhi(unsigned w) { return __uint_as_float(w & 0xffff0000u); }
__device__ __forceinline__ u16 f2bf(float f) { return (u16)(cvtpk(f, f) & 0xffffu); }
__device__ __forceinline__ float siluf(float x) { return x * __builtin_amdgcn_rcpf(1.f + __expf(-x)); }
__device__ __forceinline__ int crow(int r, int hi) { return (r & 3) + 8 * (r >> 2) + 4 * hi; }
__device__ __forceinline__ float wave_sum(float v) {
#pragma unroll
  for (int m = 32; m >= 1; m >>= 1) v += __shfl_xor(v, m);
  return v;
}
#define SBAR() __builtin_amdgcn_sched_barrier(0)
#define LAS __attribute__((address_space(3)))
__host__ __device__ __forceinline__ int wperm(int c) { return (c & ~31) + ((c >> 2) & 1) * 16 + ((c >> 3) & 3) * 4 + (c & 3); }
__device__ __forceinline__ int TID() { int t = threadIdx.x; asm volatile("" : "+v"(t)); return t; }
__device__ __forceinline__ int BID() { int b = blockIdx.x; asm volatile("" : "+s"(b)); return b; }

struct TJob { const float* src; const float* g; u16* dst; int K, N, k0, n0, n0d; };
__device__ __forceinline__ void tjob_decode(const Params& p, char* ws, int t, TJob& j) {
  int l = t / 2112, r = t % 2112;
  if (r < 1328) { int kt = r / 83, nt = r % 83; int n0 = nt * 64;
    j.src = p.in[2] + (size_t)l * 1024 * NIN; j.g = p.in[1] + l * 1024; j.dst = (u16*)(ws + OFF_WIN) + (size_t)l * NINP * 1024; j.K = 1024; j.N = NIN; j.k0 = kt * 64; j.n0 = n0; j.n0d = n0 < 3264 ? n0 : n0 + 64;
  } else if (r < 1328 + 144) { r -= 1328; int kt = r / 24, nt = r % 24;
    j.src = p.in[9] + (size_t)l * 384 * 1536; j.g = p.in[8] + l * 384; j.dst = (u16*)(ws + OFF_WUQ) + (size_t)l * 1536 * 384; j.K = 384; j.N = 1536; j.k0 = kt * 64; j.n0 = nt * 64; j.n0d = nt * 64;
  } else if (r < 1328 + 144 + 128) { r -= 1328 + 144; int kt = r / 32, nt = r % 32;
    j.src = p.in[11] + (size_t)l * 256 * 2048; j.g = p.in[10] + l * 256; j.dst = (u16*)(ws + OFF_WUKV) + (size_t)l * 2048 * 256; j.K = 256; j.N = 2048; j.k0 = kt * 64; j.n0 = nt * 64; j.n0d = nt * 64;
  } else { r -= 1328 + 144 + 128; int kt = r / 16, nt = r % 16;
    j.src = p.in[12] + (size_t)l * 2048 * 1024; j.g = nullptr; j.dst = (u16*)(ws + OFF_WOUT) + (size_t)l * 1024 * 2048; j.K = 2048; j.N = 1024; j.k0 = kt * 64; j.n0 = nt * 64; j.n0d = nt * 64; }
}
__device__ __forceinline__ void tjob_load(const TJob& j, int tid, float (&v)[8]) {
  const int nn = tid & 63, kq = tid >> 6;
#pragma unroll
  for (int i = 0; i < 8; ++i) { const int kk = kq + 8 * i; float x = j.src[(size_t)(j.k0 + kk) * j.N + j.n0 + nn]; if (j.g) x *= j.g[j.k0 + kk]; v[i] = x; }
}
__device__ void phase_prep(const Params& p, char* lds) {
  char* ws = p.ws;
  {
    float* ts = (float*)lds;
    const int tid = TID();
    const int G = gridDim.x;
    for (int base = BID(); base < 2 * 2112; base += 6 * G) {
      TJob jb[6]; float v[6][8];
#pragma unroll
      for (int i = 0; i < 6; ++i) { const int t = base + i * G; if (t < 2 * 2112) { tjob_decode(p, ws, t, jb[i]); tjob_load(jb[i], tid, v[i]); } }
      { const int nn = tid & 63, kq = tid >> 6;
#pragma unroll
        for (int i = 0; i < 6; ++i) { if (base + i * G < 2 * 2112) {
#pragma unroll
          for (int q = 0; q < 8; ++q) ts[i * 4160 + (kq + 8 * q) * 65 + nn] = v[i][q]; } } }
      __syncthreads();
      { const int nn = tid >> 3, kc = (tid & 7) * 8;
#pragma unroll
        for (int i = 0; i < 6; ++i) { if (base + i * G < 2 * 2112) {
          const float* tt = ts + i * 4160;
          u32x4 w;
          w[0] = cvtpk(tt[(kc + 0) * 65 + nn], tt[(kc + 1) * 65 + nn]);
          w[1] = cvtpk(tt[(kc + 2) * 65 + nn], tt[(kc + 3) * 65 + nn]);
          w[2] = cvtpk(tt[(kc + 4) * 65 + nn], tt[(kc + 5) * 65 + nn]);
          w[3] = cvtpk(tt[(kc + 6) * 65 + nn], tt[(kc + 7) * 65 + nn]);
          *reinterpret_cast<u32x4*>(jb[i].dst + (size_t)wperm(jb[i].n0d + nn) * jb[i].K + jb[i].k0 + kc) = w; } } }
      __syncthreads();
    }
  }
  const int gtid = BID() * NTHR + TID(), gn = gridDim.x * NTHR;
  for (int i = gtid; i < 2 * 32768; i += gn) {
    int l = i >> 15, o = i & 32767;
    ((unsigned*)(ws + OFF_WIN + ((size_t)l * NINP + 3264) * 1024 * 2))[o] = 0u;
  }
  if (gtid < 16) ((float*)(ws + OFF_LG2))[gtid] = -log1pf(expf(-p.in[7][gtid])) * 1.4426950408889634f;
  float* cosr = (float*)(ws + OFF_COSR); float* sinr = (float*)(ws + OFF_SINR);
  float* cosm = (float*)(ws + OFF_COSM); float* sinm = (float*)(ws + OFF_SINM);
  for (int i = gtid; i < 2048 * 64; i += gn) {
    int s = i >> 6, d = i & 63;
    float inv = 1.0f / powf(10000.0f, (float)(2 * d) / 128.0f);
    float ang = (float)s * inv;
    cosr[i] = cosf(ang); sinr[i] = sinf(ang);
  }
  for (int i = gtid; i < 2048 * 32; i += gn) {
    int s = i >> 5, d = i & 31;
    float inv = 1.0f / powf(10000.0f, (float)(2 * d) / 64.0f);
    float ang = (float)s * inv;
    cosm[i] = cosf(ang); sinm[i] = sinf(ang);
  }
}

__device__ void phase_norm(const float* __restrict__ X, u16* __restrict__ XN, int blk, int nblk, int row_lo = 0, int row_hi = MH) {
  const int tid_ = TID(); const int wid = tid_ >> 6, lane = tid_ & 63;
  for (int row = row_lo + blk * 8 + wid; row < row_hi; row += nblk * 8) {
    const f32x4* xr = (const f32x4*)(X + (size_t)row * DM);
    f32x4 v[4]; float ss = 0.f;
#pragma unroll
    for (int i = 0; i < 4; ++i) { v[i] = __builtin_nontemporal_load(xr + lane + 64 * i); ss += v[i][0] * v[i][0] + v[i][1] * v[i][1] + v[i][2] * v[i][2] + v[i][3] * v[i][3]; }
    ss = wave_sum(ss);
    float rstd = rsqrtf(ss * (1.0f / DM) + EPS);
#pragma unroll
    for (int i = 0; i < 4; ++i) {
      u32x2 w; w[0] = cvtpk(v[i][0] * rstd, v[i][1] * rstd); w[1] = cvtpk(v[i][2] * rstd, v[i][3] * rstd);
      *reinterpret_cast<u32x2*>(XN + (size_t)row * DM + (lane + 64 * i) * 4) = w;
    }
  }
}
__device__ void phase_final(float* __restrict__ X, const float* __restrict__ g) {
  const int tid_ = TID(); const int wid = tid_ >> 6, lane = tid_ & 63;
  for (int row = BID() * 8 + wid; row < 2 * MH; row += gridDim.x * 8) {
    f32x4* xr = (f32x4*)(X + (size_t)row * DM);
    f32x4 v[4]; float ss = 0.f;
#pragma unroll
    for (int i = 0; i < 4; ++i) { v[i] = xr[lane + 64 * i]; ss += v[i][0] * v[i][0] + v[i][1] * v[i][1] + v[i][2] * v[i][2] + v[i][3] * v[i][3]; }
    ss = wave_sum(ss);
    float rstd = rsqrtf(ss * (1.0f / DM) + EPS);
#pragma unroll
    for (int i = 0; i < 4; ++i) {
      f32x4 gg = ((const f32x4*)g)[lane + 64 * i];
      f32x4 o; o[0] = v[i][0] * rstd * gg[0]; o[1] = v[i][1] * rstd * gg[1]; o[2] = v[i][2] * rstd * gg[2]; o[3] = v[i][3] * rstd * gg[3];
      xr[lane + 64 * i] = o;
    }
  }
}

constexpr int GA_BYTES = 256 * 144, GB_BYTES = 128 * 144;
__device__ __forceinline__ int gswz(int row, int chunk) { return row * 144 + (chunk << 4); }

enum { EPI_IN = 0, EPI_Q = 1, EPI_KV = 2, EPI_OUT = 3 };
struct XcdBarrier;
__device__ __forceinline__ void xcd_barrier(const XcdBarrier& b);
struct EpiArgs {
  u16* c0; u16* c1;
  const float* resid; float* xout;
  const float* cosm; const float* sinm;
  float* ssq_q; float* ssq_kv;
  const XcdBarrier* xb; float* ssqf; const float* fg; int fuse; u16* xn_out;
};

template <int EPI, bool NORM>
__device__ __forceinline__ void gemm_tile(const u16* __restrict__ A, int lda, const u16* __restrict__ Bt, int K, int m0, int n0, char* lds, const EpiArgs& ea) {
  const int tid = TID(), wid = tid >> 6, lane = tid & 63, r32 = lane & 31, hi = lane >> 5;
  const int wm = wid >> 1, wn = wid & 1;
  char* As = lds; char* Bs = lds + 2 * GA_BYTES; float* rs = (float*)(lds + 2 * GA_BYTES + 2 * GB_BYTES);
  const int srow = tid >> 3, sch = tid & 7;
  const u16* Ag = A + (size_t)(m0 + srow) * lda + sch * 8;
  const u16* Bg = Bt + (size_t)(n0 + srow) * K + sch * 8;
  f32x16 acc[2][2];
#pragma unroll
  for (int i = 0; i < 2; ++i)
#pragma unroll
    for (int j = 0; j < 2; ++j)
#pragma unroll
      for (int r = 0; r < 16; ++r) acc[i][j][r] = 0.f;
  float ss[4] = {0.f, 0.f, 0.f, 0.f};
  bf16x8 ra[4], rb[2];
#pragma unroll
  for (int i = 0; i < 4; ++i) ra[i] = *reinterpret_cast<const bf16x8*>(Ag + (size_t)i * 64 * lda);
#pragma unroll
  for (int i = 0; i < 2; ++i) rb[i] = *reinterpret_cast<const bf16x8*>(Bg + (size_t)i * 64 * K);
  const int KT = K >> 6;
#define GWRITE(buf) do { \
    _Pragma("unroll") for (int i = 0; i < 4; ++i) { \
      *reinterpret_cast<bf16x8*>(As + (buf) * GA_BYTES + gswz(srow + 64 * i, sch)) = ra[i]; \
      if (NORM) { _Pragma("unroll") for (int j = 0; j < 8; ++j) { float f = bf2f((u16)ra[i][j]); ss[i] += f * f; } } } \
    _Pragma("unroll") for (int i = 0; i < 2; ++i) *reinterpret_cast<bf16x8*>(Bs + (buf) * GB_BYTES + gswz(srow + 64 * i, sch)) = rb[i]; } while (0)
  GWRITE(0);
  __syncthreads();
  for (int kt = 0; kt < KT; ++kt) {
    const int cur = kt & 1;
    if (kt + 1 < KT) {
      const int k0 = (kt + 1) * 64;
#pragma unroll
      for (int i = 0; i < 4; ++i) ra[i] = *reinterpret_cast<const bf16x8*>(Ag + (size_t)i * 64 * lda + k0);
#pragma unroll
      for (int i = 0; i < 2; ++i) rb[i] = *reinterpret_cast<const bf16x8*>(Bg + (size_t)i * 64 * K + k0);
    }
    SBAR();
    const char* Ab = As + cur * GA_BYTES; const char* Bb = Bs + cur * GB_BYTES;
#pragma unroll
    for (int ks = 0; ks < 4; ++ks) {
      const int ch = ks * 2 + hi;
      bf16x8 a0 = *reinterpret_cast<const bf16x8*>(Ab + gswz(wm * 64 + r32, ch));
      bf16x8 a1 = *reinterpret_cast<const bf16x8*>(Ab + gswz(wm * 64 + 32 + r32, ch));
      bf16x8 b0 = *reinterpret_cast<const bf16x8*>(Bb + gswz(wn * 64 + r32, ch));
      bf16x8 b1 = *reinterpret_cast<const bf16x8*>(Bb + gswz(wn * 64 + 32 + r32, ch));
      acc[0][0] = __builtin_amdgcn_mfma_f32_32x32x16_bf16(a0, b0, acc[0][0], 0, 0, 0);
      acc[0][1] = __builtin_amdgcn_mfma_f32_32x32x16_bf16(a0, b1, acc[0][1], 0, 0, 0);
      acc[1][0] = __builtin_amdgcn_mfma_f32_32x32x16_bf16(a1, b0, acc[1][0], 0, 0, 0);
      acc[1][1] = __builtin_amdgcn_mfma_f32_32x32x16_bf16(a1, b1, acc[1][1], 0, 0, 0);
    }
    SBAR();
    if (kt + 1 < KT) GWRITE(cur ^ 1);
    __syncthreads();
  }
#undef GWRITE
  if (NORM) {
#pragma unroll
    for (int i = 0; i < 4; ++i) {
      float s = ss[i];
      s += __shfl_xor(s, 1); s += __shfl_xor(s, 2); s += __shfl_xor(s, 4);
      if (sch == 0) rs[srow + 64 * i] = rsqrtf(s / (float)K + EPS);
    }
    __syncthreads();
  }
  if (EPI == EPI_IN) {
    const bool gate = n0 >= NYT * 128;
#pragma unroll
    for (int mi = 0; mi < 2; ++mi)
#pragma unroll
      for (int r = 0; r < 16; ++r) {
        const int row = m0 + wm * 64 + mi * 32 + crow(r, hi);
#pragma unroll
        for (int ni = 0; ni < 2; ++ni) {
          const int col = n0 + wn * 64 + ni * 32 + r32;
          float v = acc[mi][ni][r];
          if (gate) ea.c1[(size_t)row * 2048 + (col - NYT * 128)] = f2bf(siluf(v));
          else ea.c0[(size_t)row * NU + col] = f2bf(v);
        }
      }
  } else if (EPI == EPI_Q) {
    const bool rope = ((n0 + wn * 64) % 192) == 128;
#pragma unroll
    for (int mi = 0; mi < 2; ++mi)
#pragma unroll
      for (int r = 0; r < 16; ++r) {
        const int rl = wm * 64 + mi * 32 + crow(r, hi);
        const int row = m0 + rl;
        const float sc = rs[rl];
        float v0 = acc[mi][0][r] * sc, v1 = acc[mi][1][r] * sc;
        if (rope) {
          const int s = row & (SEQ - 1);
          const float c = ea.cosm[s * 32 + r32], sn = ea.sinm[s * 32 + r32];
          const float o0 = v0 * c - v1 * sn, o1 = v1 * c + v0 * sn;
          v0 = o0; v1 = o1;
        }
        const int col = n0 + wn * 64 + r32;
        ea.c0[(size_t)row * 1536 + col] = f2bf(v0);
        ea.c0[(size_t)row * 1536 + col + 32] = f2bf(v1);
      }
  } else if (EPI == EPI_KV) {
#pragma unroll
    for (int mi = 0; mi < 2; ++mi)
#pragma unroll
      for (int r = 0; r < 16; ++r) {
        const int rl = wm * 64 + mi * 32 + crow(r, hi);
        const int row = m0 + rl;
        const float sc = rs[rl];
        const int col = n0 + wn * 64 + r32;
        ea.c0[(size_t)row * 2048 + col] = f2bf(acc[mi][0][r] * sc);
        ea.c0[(size_t)row * 2048 + col + 32] = f2bf(acc[mi][1][r] * sc);
      }
  } else {
#pragma unroll
    for (int mi = 0; mi < 2; ++mi)
#pragma unroll
      for (int r = 0; r < 16; ++r) {
        const int row = m0 + wm * 64 + mi * 32 + crow(r, hi);
        const int col = n0 + wn * 64 + r32;
        const size_t o = (size_t)row * DM + col;
        ea.xout[o] = ea.resid[o] + acc[mi][0][r];
        ea.xout[o + 32] = ea.resid[o + 32] + acc[mi][1][r];
      }
  }
  if (NORM) __syncthreads();
}

constexpr int HTB = 128 * 64 * 2;
__device__ __forceinline__ int lds_byte(int r, int c) { const int st = (r >> 4) * 2 + (c >> 5), rr = r & 15, cc = c & 31, ob = rr * 64 + cc * 2; return st * 1024 + (ob ^ (((ob >> 9) & 1) << 5)); }
__device__ __forceinline__ void stage_rc(int b, int& R, int& C) { const int st = b / 1024, sb = b % 1024, swz = sb ^ (((sb >> 9) & 1) << 5); R = (st >> 1) * 16 + swz / 64; C = (st & 1) * 32 + (swz % 64) / 2; }

enum { EPI2_IN = 0, EPI2_OUT = 1, EPI2_Q = 2, EPI2_KV = 3, EPI2_OUTF = 4 };
__device__ __forceinline__ int nt_remap(int v) { return v < 9 ? v + 4 : (v < 16 ? v + 5 : (v == 20 ? 13 : v - 16)); }
template <int EPI, bool REMAP = false>
__device__ __forceinline__ void gemm256_tiles(const u16* __restrict__ A, int lda, const u16* __restrict__ Bt, int K, int t0, int t1, int tstep, int xcd, int mbits, char* shm, const EpiArgs& ea) {
  if (t0 >= t1) return;
  const int tid = TID(), wid = tid >> 6, lane = tid & 63, wr = wid >> 2, wc = wid & 3, fr = lane & 15, fq = lane >> 4;
  int r0, c0; stage_rc(tid * 16, r0, c0);
  int tcur = t0;
  int brow = ((xcd << mbits) + (tcur & ((1 << mbits) - 1))) * 256, bcol = (REMAP ? nt_remap(tcur >> mbits) : (tcur >> mbits)) * 256;
  const size_t ahalf = (size_t)128 * lda, bhalf = (size_t)128 * K, aq = (size_t)64 * lda, bq = (size_t)64 * K;
  char* sdst = shm + tid * 16;
#define SA(b, h) (((b) * 2 + (h)) * HTB)
#define SB(b, h) ((4 + (b) * 2 + (h)) * HTB)
#define GLDS(g, off) __builtin_amdgcn_global_load_lds((const unsigned*)(g), (LAS unsigned*)(sdst + (off)), 16, 0, 0)
#define STAGE_AP(P_, off, h, kt) do { GLDS((P_) + (h) * ahalf + (kt) * 64, (off)); GLDS((P_) + aq + (h) * ahalf + (kt) * 64, (off) + 8192); } while (0)
#define STAGE_BP(P_, off, h, kt) do { GLDS((P_) + (h) * bhalf + (kt) * 64, (off)); GLDS((P_) + bq + (h) * bhalf + (kt) * 64, (off) + 8192); } while (0)
#define STAGE_A(off, h, kt) STAGE_AP(Ag0, off, h, kt)
#define STAGE_B(off, h, kt) STAGE_BP(Bg0, off, h, kt)
#define LDA(dst, b, h) _Pragma("unroll") for (int m = 0; m < 4; ++m) _Pragma("unroll") for (int k = 0; k < 2; ++k) \
    dst[m][k] = *reinterpret_cast<const bf16x8*>(shm + SA(b, h) + lds_byte(wr * 64 + m * 16 + fr, k * 32 + fq * 8))
#define LDB(dst, b, h) _Pragma("unroll") for (int n = 0; n < 2; ++n) _Pragma("unroll") for (int k = 0; k < 2; ++k) \
    dst[n][k] = *reinterpret_cast<const bf16x8*>(shm + SB(b, h) + lds_byte(wc * 32 + n * 16 + fr, k * 32 + fq * 8))
#define MMA(ai, bj, At_, Bt_) do { __builtin_amdgcn_s_setprio(3); \
    _Pragma("unroll") for (int m = 0; m < 4; ++m) _Pragma("unroll") for (int n = 0; n < 2; ++n) _Pragma("unroll") for (int k = 0; k < 2; ++k) \
      acc[ai][bj][m][n] = __builtin_amdgcn_mfma_f32_16x16x32_bf16(Bt_[n][k], At_[m][k], acc[ai][bj][m][n], 0, 0, 0); \
    __builtin_amdgcn_s_setprio(0); } while (0)
#define WAIT_V(n) asm volatile("s_waitcnt vmcnt(" #n ")" ::: "memory")
#define WAIT_L(n) asm volatile("s_waitcnt lgkmcnt(" #n ")" ::: "memory")
#define BAR __builtin_amdgcn_s_barrier()
#define SCHED __builtin_amdgcn_sched_barrier(0)
  const int nt = K >> 6;
  { const u16* pa_ = A + (size_t)(brow + r0) * lda + c0; const u16* pb_ = Bt + (size_t)(bcol + r0) * K + c0;
    STAGE_BP(pb_, SB(0, 0), 0, 0); STAGE_AP(pa_, SA(0, 0), 0, 0);
    STAGE_BP(pb_, SB(0, 1), 1, 0); STAGE_AP(pa_, SA(0, 1), 1, 0); }
  for (;;) {
  const u16* Ag0; const u16* Bg0;
  { int r0n, c0n; stage_rc(TID() * 16, r0n, c0n); Ag0 = A + (size_t)(brow + r0n) * lda + c0n; Bg0 = Bt + (size_t)(bcol + r0n) * K + c0n; }
  f32x4 acc[2][2][4][2];
#pragma unroll
  for (int a = 0; a < 2; ++a)
#pragma unroll
    for (int b = 0; b < 2; ++b)
#pragma unroll
      for (int m = 0; m < 4; ++m)
#pragma unroll
        for (int n = 0; n < 2; ++n) acc[a][b][m][n] = (f32x4){0.f, 0.f, 0.f, 0.f};
  bf16x8 At[4][2], B0[2][2], B1[2][2];
  if (wr == 1) BAR;
  WAIT_V(4); BAR;
  STAGE_B(SB(1, 0), 0, 1); STAGE_A(SA(1, 0), 0, 1); STAGE_B(SB(1, 1), 1, 1);
  WAIT_V(6); BAR;
  for (int t = 0; t < nt - 2; t += 2) {
    LDB(B0, 0, 0); SCHED; LDA(At, 0, 0); STAGE_A(SA(1, 1), 1, t + 1);
    WAIT_L(8); BAR; WAIT_L(0); MMA(0, 0, At, B0); BAR; SCHED;
    LDB(B1, 0, 1); STAGE_B(SB(0, 0), 0, t + 2);
    BAR; WAIT_L(0); MMA(0, 1, At, B1); BAR;
    LDA(At, 0, 1); STAGE_A(SA(0, 0), 0, t + 2);
    BAR; WAIT_L(0); MMA(1, 0, At, B0); BAR; SCHED;
    STAGE_B(SB(0, 1), 1, t + 2);
    WAIT_V(6); BAR; MMA(1, 1, At, B1); BAR;
    LDB(B0, 1, 0); SCHED; LDA(At, 1, 0); STAGE_A(SA(0, 1), 1, t + 2);
    WAIT_L(8); BAR; WAIT_L(0); MMA(0, 0, At, B0); BAR; SCHED;
    LDB(B1, 1, 1); STAGE_B(SB(1, 0), 0, t + 3);
    BAR; WAIT_L(0); MMA(0, 1, At, B1); BAR;
    LDA(At, 1, 1); STAGE_A(SA(1, 0), 0, t + 3);
    BAR; WAIT_L(0); MMA(1, 0, At, B0); BAR; SCHED;
    STAGE_B(SB(1, 1), 1, t + 3);
    WAIT_V(6); BAR; MMA(1, 1, At, B1); BAR;
  }
  { LDB(B0, 0, 0); LDA(At, 0, 0); STAGE_A(SA(1, 1), 1, nt - 1);
    BAR; WAIT_L(0); MMA(0, 0, At, B0); BAR;
    LDB(B1, 0, 1); BAR; WAIT_L(0); MMA(0, 1, At, B1); BAR;
    LDA(At, 0, 1); WAIT_V(4); BAR; WAIT_L(0); MMA(1, 0, At, B0); MMA(1, 1, At, B1); BAR; }
  { LDB(B0, 1, 0); LDA(At, 1, 0); WAIT_V(2); BAR; WAIT_L(0); MMA(0, 0, At, B0); BAR;
    LDB(B1, 1, 1); WAIT_V(0); BAR; WAIT_L(0); MMA(0, 1, At, B1); BAR;
    LDA(At, 1, 1); BAR; WAIT_L(0); MMA(1, 0, At, B0); MMA(1, 1, At, B1); BAR; }
  if (wr == 0) BAR;
  const int tnext = tcur + tstep; const bool more = tnext < t1;
  const int cbrow = brow, cbcol = bcol;
  if (more) {
    brow = ((xcd << mbits) + (tnext & ((1 << mbits) - 1))) * 256; bcol = (REMAP ? nt_remap(tnext >> mbits) : (tnext >> mbits)) * 256;
    int r0n, c0n; stage_rc(TID() * 16, r0n, c0n);
    const u16* pa_ = A + (size_t)(brow + r0n) * lda + c0n; const u16* pb_ = Bt + (size_t)(bcol + r0n) * K + c0n;
    STAGE_BP(pb_, SB(0, 0), 0, 0); STAGE_AP(pa_, SA(0, 0), 0, 0);
    STAGE_BP(pb_, SB(0, 1), 1, 0); STAGE_AP(pa_, SA(0, 1), 1, 0);
  }
  {
  const int brow = cbrow, bcol = cbcol;
  const int tid2 = TID(), wid2 = tid2 >> 6, lane2 = tid2 & 63, wr = wid2 >> 2, wc = wid2 & 3, fr = lane2 & 15, fq = lane2 >> 4;
  if (EPI == EPI2_OUTF) {
#pragma unroll
    for (int ai = 0; ai < 2; ++ai)
#pragma unroll
      for (int m = 0; m < 4; ++m) {
        const int row = brow + ai * 128 + wr * 64 + m * 16 + fr;
        float sq = 0.f;
#pragma unroll
        for (int bj = 0; bj < 2; ++bj) {
          const size_t o = (size_t)row * DM + bcol + bj * 128 + wc * 32 + 8 * fq;
          const f32x4 q0 = __builtin_nontemporal_load(reinterpret_cast<const f32x4*>(ea.resid + o)), q1 = __builtin_nontemporal_load(reinterpret_cast<const f32x4*>(ea.resid + o + 4));
          const f32x4 v0 = q0 + acc[ai][bj][m][0], v1 = q1 + acc[ai][bj][m][1];
          acc[ai][bj][m][0] = v0; acc[ai][bj][m][1] = v1;
          sq += v0[0] * v0[0] + v0[1] * v0[1] + v0[2] * v0[2] + v0[3] * v0[3] + v1[0] * v1[0] + v1[1] * v1[1] + v1[2] * v1[2] + v1[3] * v1[3];
        }
        sq += __shfl_xor(sq, 16); sq += __shfl_xor(sq, 32);
        if (fq == 0) atomicAdd(ea.ssqf + row, sq);
      }
    xcd_barrier(*ea.xb);
#pragma unroll
    for (int ai = 0; ai < 2; ++ai)
#pragma unroll
      for (int m = 0; m < 4; ++m) {
        const int row = brow + ai * 128 + wr * 64 + m * 16 + fr;
        const float rstd = rsqrtf(ea.ssqf[row] * (1.0f / DM) + EPS);
#pragma unroll
        for (int bj = 0; bj < 2; ++bj) {
          const int col = bcol + bj * 128 + wc * 32 + 8 * fq;
          if (ea.xn_out) {
            const f32x4 v0 = acc[ai][bj][m][0], v1 = acc[ai][bj][m][1];
            *reinterpret_cast<f32x4*>(ea.xout + (size_t)row * DM + col) = v0;
            *reinterpret_cast<f32x4*>(ea.xout + (size_t)row * DM + col + 4) = v1;
            u32x4 w; w[0] = cvtpk(v0[0] * rstd, v0[1] * rstd); w[1] = cvtpk(v0[2] * rstd, v0[3] * rstd); w[2] = cvtpk(v1[0] * rstd, v1[1] * rstd); w[3] = cvtpk(v1[2] * rstd, v1[3] * rstd);
            *reinterpret_cast<u32x4*>(ea.xn_out + (size_t)row * DM + col) = w;
          } else {
            const f32x4 g0 = *reinterpret_cast<const f32x4*>(ea.fg + col), g1 = *reinterpret_cast<const f32x4*>(ea.fg + col + 4);
            *reinterpret_cast<f32x4*>(ea.xout + (size_t)row * DM + col) = acc[ai][bj][m][0] * rstd * g0;
            *reinterpret_cast<f32x4*>(ea.xout + (size_t)row * DM + col + 4) = acc[ai][bj][m][1] * rstd * g1;
          }
        }
      }
  } else
#pragma unroll
  for (int ai = 0; ai < 2; ++ai)
#pragma unroll
    for (int m = 0; m < 4; ++m) {
      const int row = brow + ai * 128 + wr * 64 + m * 16 + fr;
#pragma unroll
      for (int bj = 0; bj < 2; ++bj) {
        const int col = bcol + bj * 128 + wc * 32 + 8 * fq;
        const f32x4 v0 = acc[ai][bj][m][0], v1 = acc[ai][bj][m][1];
        if (EPI == EPI2_Q || EPI == EPI2_KV) {
          const float ssv = (EPI == EPI2_Q ? ea.ssq_q : ea.ssq_kv)[row];
          const float sc = rsqrtf(ssv * (EPI == EPI2_Q ? (1.0f / 384.0f) : (1.0f / 256.0f)) + EPS);
          u32x4 w;
          w[0] = cvtpk(v0[0] * sc, v0[1] * sc); w[1] = cvtpk(v0[2] * sc, v0[3] * sc); w[2] = cvtpk(v1[0] * sc, v1[1] * sc); w[3] = cvtpk(v1[2] * sc, v1[3] * sc);
          *reinterpret_cast<u32x4*>(ea.c0 + (size_t)row * (EPI == EPI2_Q ? 1536 : 2048) + col) = w;
        } else if (EPI == EPI2_IN) {
          if (bcol >= 2560 && bcol <= 3072) {
            const int cg0 = bcol + bj * 128;
            if (cg0 < 3200) {
              float sq = v0[0] * v0[0] + v0[1] * v0[1] + v0[2] * v0[2] + v0[3] * v0[3] + v1[0] * v1[0] + v1[1] * v1[1] + v1[2] * v1[2] + v1[3] * v1[3];
              sq += __shfl_xor(sq, 16); sq += __shfl_xor(sq, 32);
              if (fq == 0) atomicAdd((cg0 < 2944 ? ea.ssq_q : ea.ssq_kv) + row, sq);
            }
          }
          u32x4 w;
          if (bcol >= NYT2 * 256) {
            w[0] = cvtpk(siluf(v0[0]), siluf(v0[1])); w[1] = cvtpk(siluf(v0[2]), siluf(v0[3]));
            w[2] = cvtpk(siluf(v1[0]), siluf(v1[1])); w[3] = cvtpk(siluf(v1[2]), siluf(v1[3]));
            *reinterpret_cast<u32x4*>(ea.c1 + (size_t)row * 2048 + (col - NYT2 * 256)) = w;
          } else {
            w[0] = cvtpk(v0[0], v0[1]); w[1] = cvtpk(v0[2], v0[3]); w[2] = cvtpk(v1[0], v1[1]); w[3] = cvtpk(v1[2], v1[3]);
            *reinterpret_cast<u32x4*>(ea.c0 + (size_t)row * NU + col) = w;
          }
        } else {
          const size_t o = (size_t)row * DM + col;
          const f32x4 q0 = __builtin_nontemporal_load(reinterpret_cast<const f32x4*>(ea.resid + o)), q1 = __builtin_nontemporal_load(reinterpret_cast<const f32x4*>(ea.resid + o + 4));
          *reinterpret_cast<f32x4*>(ea.xout + o) = q0 + v0;
          *reinterpret_cast<f32x4*>(ea.xout + o + 4) = q1 + v1;
        }
      }
    }
  }
  asm volatile("s_waitcnt vmcnt(0)" ::: "memory");
  __syncthreads();
  if (!more) break;
  tcur = tnext;
  }
#undef SA
#undef SB
#undef GLDS
#undef STAGE_A
#undef STAGE_AP
#undef STAGE_BP
#undef STAGE_B
#undef LDA
#undef LDB
#undef MMA
#undef WAIT_V
#undef WAIT_L
#undef BAR
#undef SCHED
}

__device__ void conv_tile(const u16* __restrict__ U, u16* __restrict__ Y, const float* __restrict__ dw_w, const float* __restrict__ dw_b,
                          const float* __restrict__ ln_g, const float* __restrict__ ln_b, int t0, char* lds, bool dowrite = true) {
  float* hs = (float*)lds;
  const int tid = TID(), wid = tid >> 6, lane = tid & 63;
  const int bb = t0 & ~(SEQ - 1), s0 = t0 & (SEQ - 1);
  {
    u32x4 av[8], gv[8];
#pragma unroll
    for (int it = 0; it < 8; ++it) {
      const int idx = tid + it * NTHR;
      const int rr = idx >> 6, ch = (idx & 63) * 8;
      const int s = s0 - 15 + rr;
      av[it] = (u32x4){0u, 0u, 0u, 0u}; gv[it] = (u32x4){0u, 0u, 0u, 0u};
      if (idx < 62 * 64 && s >= 0 && s < SEQ) {
        const u16* up = U + (size_t)(bb + s) * NU + ch;
        av[it] = *reinterpret_cast<const u32x4*>(up);
        gv[it] = *reinterpret_cast<const u32x4*>(up + 512);
      }
    }
#pragma unroll
    for (int it = 0; it < 8; ++it) {
      const int idx = tid + it * NTHR;
      const int rr = idx >> 6, ch = (idx & 63) * 8;
      if (idx < 62 * 64) {
        f32x4 h0, h1;
#pragma unroll
        for (int j = 0; j < 4; ++j) {
          float a0 = bflo(av[it][j]), a1 = bfhi(av[it][j]), g0 = bflo(gv[it][j]), g1 = bfhi(gv[it][j]);
          float x0 = a0 * __builtin_amdgcn_rcpf(1.f + __expf(-g0)), x1 = a1 * __builtin_amdgcn_rcpf(1.f + __expf(-g1));
          if (j < 2) { h0[2 * j] = x0; h0[2 * j + 1] = x1; } else { h1[2 * (j - 2)] = x0; h1[2 * (j - 2) + 1] = x1; }
        }
        *reinterpret_cast<f32x4*>(hs + rr * 512 + ch) = h0;
        *reinterpret_cast<f32x4*>(hs + rr * 512 + ch + 4) = h1;
      }
    }
  }
  __syncthreads();
  const int c = tid;
  float w[31];
#pragma unroll
  for (int k = 0; k < 31; ++k) w[k] = dw_w[k * 512 + c];
  const float bias = dw_b[c];
  float outv[32];
#pragma unroll
  for (int tb = 0; tb < 4; ++tb) {
    float hv[38];
#pragma unroll
    for (int i = 0; i < 38; ++i) hv[i] = hs[(tb * 8 + i) * 512 + c];
#pragma unroll
    for (int t = 0; t < 8; ++t) {
      float a = bias;
#pragma unroll
      for (int k = 0; k < 31; ++k) a = fmaf(w[k], hv[t + k], a);
      outv[tb * 8 + t] = a;
    }
  }
  __syncthreads();
#pragma unroll
  for (int t = 0; t < 32; ++t) hs[t * 512 + c] = outv[t];
  __syncthreads();
#pragma unroll
  for (int q = 0; q < 4; ++q) {
    const int t = wid * 4 + q;
    const int ch = lane * 8;
    f32x4 v0 = *reinterpret_cast<const f32x4*>(hs + t * 512 + ch);
    f32x4 v1 = *reinterpret_cast<const f32x4*>(hs + t * 512 + ch + 4);
    float x[8] = {v0[0], v0[1], v0[2], v0[3], v1[0], v1[1], v1[2], v1[3]};
    float s = 0.f;
#pragma unroll
    for (int j = 0; j < 8; ++j) s += x[j];
    const float mu = wave_sum(s) * (1.f / 512.f);
    float vs = 0.f;
#pragma unroll
    for (int j = 0; j < 8; ++j) { x[j] -= mu; vs += x[j] * x[j]; }
    const float rstd = rsqrtf(wave_sum(vs) * (1.f / 512.f) + EPS);
    u16* yp = Y + (size_t)(t0 + t) * 2048 + ch;
    u32x4 gt = *reinterpret_cast<const u32x4*>(yp);
    float o[8];
#pragma unroll
    for (int j = 0; j < 8; ++j) {
      float hn = x[j] * rstd * ln_g[ch + j] + ln_b[ch + j];
      float gj = (j & 1) ? bfhi(gt[j >> 1]) : bflo(gt[j >> 1]);
      o[j] = siluf(hn) * gj;
    }
    u32x4 ow; ow[0] = cvtpk(o[0], o[1]); ow[1] = cvtpk(o[2], o[3]); ow[2] = cvtpk(o[4], o[5]); ow[3] = cvtpk(o[6], o[7]);
    if (dowrite) *reinterpret_cast<u32x4*>(yp) = ow;
  }
  __syncthreads();
}

__device__ void rope_rows(u16* __restrict__ U, u16* __restrict__ K3, const float* __restrict__ lg2, const float* __restrict__ cosr, const float* __restrict__ sinr, const float* __restrict__ cosm, const float* __restrict__ sinm, bool dowrite = true) {
  const int t = TID();
  const int isk = t >> 8, hh = (t >> 6) & 3, d = t & 63;
  for (int m = BID(); m < MH; m += gridDim.x) {
    const int s = m & (SEQ - 1);
    u16* base = U + (size_t)m * NU + 1024 + isk * 512 + hh * 128;
    float x1 = bf2f(base[d]), x2 = bf2f(base[d + 64]);
    float c = cosr[s * 64 + d], sn = sinr[s * 64 + d];
    float o1 = x1 * c - x2 * sn, o2 = x2 * c + x1 * sn;
    if (isk) {
      o1 *= 0.08838834764831845f; o2 *= 0.08838834764831845f;
      u16* kd = K3 + (size_t)m * 512 + hh * 128;
      if (dowrite) { kd[d] = f2bf(o1); kd[d + 64] = f2bf(o2); }
    } else if (dowrite) { base[d] = f2bf(o1); base[d + 64] = f2bf(o2); }
    if (t < 32) {
      u16* kb = U + (size_t)m * NU + 3200;
      float y1 = bf2f(kb[t]), y2 = bf2f(kb[t + 32]);
      float cm = cosm[s * 32 + t], sm = sinm[s * 32 + t];
      if (dowrite) { kb[t] = f2bf(y1 * cm - y2 * sm); kb[t + 32] = f2bf(y2 * cm + y1 * sm); }
    }
  }
}

template <int DQK> __device__ __forceinline__ int kswz(int row, int cb) {
  return row * (DQK * 2 + 16) + cb;
}
__device__ __forceinline__ int v_st(int k, int c) { const int kk = (k & ~0xC) | ((k & 4) << 1) | ((k & 8) >> 1); return ((kk >> 3) * 4 + (c >> 5)) * 512 + ((kk & 7) * 32 + (c & 31)) * 2; }
__device__ __forceinline__ int v_rd_base(int lane) { return ((lane & 3) << 3) | (((lane >> 2) & 3) << 6) | (((lane >> 4) & 1) << 5) | (((lane >> 5) & 1) << 8); }
constexpr int v_rd_off(int d0, int ks, int half) { return d0 * 512 + ks * 4096 + half * 2048; }
template <int OFF> __device__ __forceinline__ s16x4 tr_read(int vb) {
  s16x4 r; asm volatile("ds_read_b64_tr_b16 %0, %1 offset:%2" : "=&v"(r) : "v"(vb), "i"(OFF) : "memory"); return r;
}
template <int D0> __device__ __forceinline__ void pv_one(f32x16& od, int vb, bf16x8 pa0, bf16x8 pa1, bf16x8 pa2, bf16x8 pa3) {
  const s16x4 l0 = tr_read<v_rd_off(D0, 0, 0)>(vb), h0 = tr_read<v_rd_off(D0, 0, 1)>(vb), l1 = tr_read<v_rd_off(D0, 1, 0)>(vb), h1 = tr_read<v_rd_off(D0, 1, 1)>(vb);
  const s16x4 l2 = tr_read<v_rd_off(D0, 2, 0)>(vb), h2 = tr_read<v_rd_off(D0, 2, 1)>(vb), l3 = tr_read<v_rd_off(D0, 3, 0)>(vb), h3 = tr_read<v_rd_off(D0, 3, 1)>(vb);
  asm volatile("s_waitcnt lgkmcnt(0)" ::: "memory"); SBAR();
#define PK(L, H) (bf16x8){L[0], L[1], L[2], L[3], H[0], H[1], H[2], H[3]}
  od = __builtin_amdgcn_mfma_f32_32x32x16_bf16(pa0, PK(l0, h0), od, 0, 0, 0);
  od = __builtin_amdgcn_mfma_f32_32x32x16_bf16(pa1, PK(l1, h1), od, 0, 0, 0);
  od = __builtin_amdgcn_mfma_f32_32x32x16_bf16(pa2, PK(l2, h2), od, 0, 0, 0);
  od = __builtin_amdgcn_mfma_f32_32x32x16_bf16(pa3, PK(l3, h3), od, 0, 0, 0);
#undef PK
}
__device__ __forceinline__ void pv_d0(f32x16* o, int vb, bf16x8 pa0, bf16x8 pa1, bf16x8 pa2, bf16x8 pa3) {
  pv_one<0>(o[0], vb, pa0, pa1, pa2, pa3); pv_one<1>(o[1], vb, pa0, pa1, pa2, pa3); pv_one<2>(o[2], vb, pa0, pa1, pa2, pa3); pv_one<3>(o[3], vb, pa0, pa1, pa2, pa3);
}
constexpr float MLA_SCALE = 0.07216878364870322f;
constexpr float MLA_THR = 8.f;
__device__ __forceinline__ void partialSM(f32x16& p0, f32x16& p1, float& m_reg, float& mn, float& alpha) {
  constexpr float C = MLA_SCALE * 1.4426950408889634f;
  float pmax = p0[0];
#pragma unroll
  for (int r = 1; r < 16; ++r) pmax = fmaxf(pmax, p0[r]);
#pragma unroll
  for (int r = 0; r < 16; ++r) pmax = fmaxf(pmax, p1[r]);
  { auto rr = __builtin_amdgcn_permlane32_swap(__float_as_uint(pmax), __float_as_uint(pmax), false, false);
    pmax = fmaxf(__uint_as_float(rr[0]), __uint_as_float(rr[1])); }
  if (__builtin_expect(__all(pmax - m_reg <= MLA_THR / MLA_SCALE), 1)) { mn = m_reg; alpha = 1.f; }
  else { mn = fmaxf(m_reg, pmax); alpha = __builtin_amdgcn_exp2f((m_reg - mn) * C); m_reg = mn; }
  float mnC = -mn * C;
#pragma unroll
  for (int r = 0; r < 16; ++r) p0[r] = fmaf(p0[r], C, mnC);
#pragma unroll
  for (int r = 0; r < 16; ++r) p1[r] = fmaf(p1[r], C, mnC);
#pragma unroll
  for (int r = 0; r < 16; ++r) p0[r] = __builtin_amdgcn_exp2f(p0[r]);
}
#define PK4(P, BASE, OUT) do { unsigned a0 = cvtpk(P[BASE + 0], P[BASE + 1]), a1 = cvtpk(P[BASE + 2], P[BASE + 3]);   \
    unsigned b0 = cvtpk(P[BASE + 4], P[BASE + 5]), b1 = cvtpk(P[BASE + 6], P[BASE + 7]);                              \
    auto r0 = __builtin_amdgcn_permlane32_swap(a0, b0, false, false); auto r1 = __builtin_amdgcn_permlane32_swap(a1, b1, false, false); \
    u32x4 w = {r0[0], r1[0], r0[1], r1[1]}; OUT = *reinterpret_cast<bf16x8*>(&w); } while (0)
__device__ __forceinline__ void finishSM(f32x16& p0, f32x16& p1, float alpha, float& l_reg, bf16x8& pa0, bf16x8& pa1, bf16x8& pa2, bf16x8& pa3) {
#pragma unroll
  for (int r = 0; r < 16; ++r) p1[r] = __builtin_amdgcn_exp2f(p1[r]);
  float ps = 0;
#pragma unroll
  for (int r = 0; r < 16; ++r) ps += p0[r];
#pragma unroll
  for (int r = 0; r < 16; ++r) ps += p1[r];
  { auto rr = __builtin_amdgcn_permlane32_swap(__float_as_uint(ps), __float_as_uint(ps), false, false);
    ps = __uint_as_float(rr[0]) + __uint_as_float(rr[1]); }
  l_reg = l_reg * alpha + ps;
  PK4(p0, 0, pa0); PK4(p0, 8, pa1); PK4(p1, 0, pa2); PK4(p1, 8, pa3);
}
__device__ __forceinline__ void packP(f32x16& p0, f32x16& p1, bf16x8& pa0, bf16x8& pa1, bf16x8& pa2, bf16x8& pa3) {
  PK4(p0, 0, pa0); PK4(p0, 8, pa1); PK4(p1, 0, pa2); PK4(p1, 8, pa3);
}
__device__ __forceinline__ void ret_decay(f32x16& p0, f32x16& p1, int iq, int j0, int hi, float lf2, float nlb2) {
#pragma unroll
  for (int r = 0; r < 16; ++r) {
    const float d0 = (float)(iq - (j0 + crow(r, hi)));
    const float d1 = d0 - 32.f;
    p0[r] *= __builtin_amdgcn_exp2f(d0 * (d0 >= 0.f ? lf2 : nlb2));
    p1[r] *= __builtin_amdgcn_exp2f(d1 * (d1 >= 0.f ? lf2 : nlb2));
  }
}
template <int DQK> __device__ __forceinline__ void qkt(f32x16& p0, f32x16& p1, const char* Ks, const bf16x8* qr, const char* qsave, int r32, int hi) {
#pragma unroll
  for (int r = 0; r < 16; ++r) { p0[r] = 0.f; p1[r] = 0.f; }
#pragma unroll
  for (int d0 = 0; d0 < DQK / 16; ++d0) { const int cb = (d0 * 16 + hi * 8) * 2;
    bf16x8 b0 = *reinterpret_cast<const bf16x8*>(Ks + kswz<DQK>(r32, cb));
    bf16x8 b1 = *reinterpret_cast<const bf16x8*>(Ks + kswz<DQK>(32 + r32, cb));
    p0 = __builtin_amdgcn_mfma_f32_32x32x16_bf16(b0, qr[d0], p0, 0, 0, 0);
    p1 = __builtin_amdgcn_mfma_f32_32x32x16_bf16(b1, qr[d0], p1, 0, 0, 0); }
}

constexpr int SHM_V = 64 * 128 * 2;
template <int MODE>
__device__ __forceinline__ void attn_item(const u16* __restrict__ Qp, int ldq, const u16* __restrict__ Kp, int ldk, const u16* __restrict__ Krp,
                                          const u16* __restrict__ Vp, int ldv, u16* __restrict__ Yp, int qpos0, float lf2, float nlb2, char* lds, bool dowrite = true, const float* __restrict__ cosm_ = nullptr, const float* __restrict__ sinm_ = nullptr,
                                          const u16* __restrict__ Pst = nullptr, int nblk = 0) {
  constexpr int DQK = MODE == 0 ? 192 : 128;
  constexpr int ND0 = DQK / 16;
  constexpr int SHM_K = 64 * (DQK * 2 + 16);
  const int tid = TID(), wid = tid >> 6, lane = tid & 63, r32 = lane & 31, hi = lane >> 5;
  char* V_lds = lds; char* K_lds = lds + 2 * SHM_V;
  float* wsp = (float*)(lds + 2 * SHM_V + 2 * SHM_K) + wid * 64; float* li_l = wsp; float* al_l = wsp + 32;
  float m_reg = -1e30f, l_reg = 0.f;
  f32x16 o[4];
#pragma unroll
  for (int d = 0; d < 4; ++d)
#pragma unroll
    for (int r = 0; r < 16; ++r) o[d][r] = 0.f;
  bf16x8 qr[ND0];
  const u16* Qw = Qp + (size_t)(wid * 32 + r32) * ldq + hi * 8;
  char* qsave = lds + 2 * SHM_V + 2 * SHM_K + 2048 + wid * 4096 + lane * 16;
#pragma unroll
  for (int d0 = 0; d0 < 8; ++d0) qr[d0] = *reinterpret_cast<const bf16x8*>(Qw + d0 * 16);
  if (MODE == 0) {
    bf16x8 f8 = *reinterpret_cast<const bf16x8*>(Qw + 128), f9 = *reinterpret_cast<const bf16x8*>(Qw + 144);
    bf16x8 f10 = *reinterpret_cast<const bf16x8*>(Qw + 160), f11 = *reinterpret_cast<const bf16x8*>(Qw + 176);
    const int spos = qpos0 + wid * 32 + r32;
    const float* cp = cosm_ + spos * 32 + hi * 8; const float* sp = sinm_ + spos * 32 + hi * 8;
    unsigned o8[4], o9[4], o10[4], o11[4];
    const f32x4 cA0 = *reinterpret_cast<const f32x4*>(cp), cA1 = *reinterpret_cast<const f32x4*>(cp + 4), cB0 = *reinterpret_cast<const f32x4*>(cp + 16), cB1 = *reinterpret_cast<const f32x4*>(cp + 20);
    const f32x4 sA0 = *reinterpret_cast<const f32x4*>(sp), sA1 = *reinterpret_cast<const f32x4*>(sp + 4), sB0 = *reinterpret_cast<const f32x4*>(sp + 16), sB1 = *reinterpret_cast<const f32x4*>(sp + 20);
#pragma unroll
    for (int jj = 0; jj < 4; ++jj) {
      float r8[2], r9[2], r10[2], r11[2];
#pragma unroll
      for (int e = 0; e < 2; ++e) { const int j = 2 * jj + e;
        const float c0 = j < 4 ? cA0[j & 3] : cA1[j & 3], s0 = j < 4 ? sA0[j & 3] : sA1[j & 3], c1 = j < 4 ? cB0[j & 3] : cB1[j & 3], s1 = j < 4 ? sB0[j & 3] : sB1[j & 3];
        const float x8 = bf2f((u16)f8[j]), x10 = bf2f((u16)f10[j]), x9 = bf2f((u16)f9[j]), x11 = bf2f((u16)f11[j]);
        r8[e] = x8 * c0 - x10 * s0; r10[e] = x10 * c0 + x8 * s0; r9[e] = x9 * c1 - x11 * s1; r11[e] = x11 * c1 + x9 * s1; }
      o8[jj] = cvtpk(r8[0], r8[1]); o9[jj] = cvtpk(r9[0], r9[1]); o10[jj] = cvtpk(r10[0], r10[1]); o11[jj] = cvtpk(r11[0], r11[1]);
    }
    { u32x4 w8 = {o8[0], o8[1], o8[2], o8[3]}, w9 = {o9[0], o9[1], o9[2], o9[3]}, w10 = {o10[0], o10[1], o10[2], o10[3]}, w11 = {o11[0], o11[1], o11[2], o11[3]};
      qr[ND0 - 4] = *reinterpret_cast<bf16x8*>(&w8); qr[ND0 - 3] = *reinterpret_cast<bf16x8*>(&w9); qr[ND0 - 2] = *reinterpret_cast<bf16x8*>(&w10); qr[ND0 - 1] = *reinterpret_cast<bf16x8*>(&w11); }
  }
  const int iq = qpos0 + wid * 32 + r32;
  const int sr = tid >> 4, sc = (tid & 15) * 8, vst0 = v_st(sr, sc), vst1 = v_st(32 + sr, sc);
  const int krr = tid >> 3, krc = (tid & 7) * 8;
  const int vb0 = (int)(uintptr_t)V_lds + v_rd_base(lane);
  bf16x8 vs0, vs1, ks0, ks1, kr0;
#define SLOAD(k0) do { vs0 = *reinterpret_cast<const bf16x8*>(Vp + (size_t)((k0) + sr) * ldv + sc); vs1 = *reinterpret_cast<const bf16x8*>(Vp + (size_t)((k0) + 32 + sr) * ldv + sc); \
    ks0 = *reinterpret_cast<const bf16x8*>(Kp + (size_t)((k0) + sr) * ldk + sc); ks1 = *reinterpret_cast<const bf16x8*>(Kp + (size_t)((k0) + 32 + sr) * ldk + sc); \
    if (MODE == 0) kr0 = *reinterpret_cast<const bf16x8*>(Krp + (size_t)((k0) + krr) * NU + krc); } while (0)
#define SWRITE(b) do { *reinterpret_cast<bf16x8*>(V_lds + (b) * SHM_V + vst0) = vs0; *reinterpret_cast<bf16x8*>(V_lds + (b) * SHM_V + vst1) = vs1; \
    *reinterpret_cast<bf16x8*>(K_lds + (b) * SHM_K + kswz<DQK>(sr, sc * 2)) = ks0; *reinterpret_cast<bf16x8*>(K_lds + (b) * SHM_K + kswz<DQK>(32 + sr, sc * 2)) = ks1; \
    if (MODE == 0) *reinterpret_cast<bf16x8*>(K_lds + (b) * SHM_K + kswz<DQK>(krr, (128 + krc) * 2)) = kr0; } while (0)
#define RESC(a) do { if (MODE == 0) { if (__any((a) < 1.f)) { if (hi == 0) al_l[r32] = (a); asm volatile("s_waitcnt lgkmcnt(0)" ::: "memory"); \
    _Pragma("unroll") for (int d = 0; d < 4; ++d) _Pragma("unroll") for (int r = 0; r < 16; ++r) o[d][r] *= al_l[crow(r, hi)]; } } } while (0)
#define PART(P0, P1, MN, AL, J0) do { if (MODE == 0) partialSM(P0, P1, m_reg, MN, AL); else ret_decay(P0, P1, iq, (J0) + qpos0, hi, lf2, nlb2); } while (0)
#define FIN(P0, P1, AL) do { if (MODE == 0) finishSM(P0, P1, AL, l_reg, pa0, pa1, pa2, pa3); else packP(P0, P1, pa0, pa1, pa2, pa3); } while (0)
  f32x16 pA0, pA1, pB0, pB1; float mnA = 0.f, mnB = 0.f, alA = 1.f, alB = 1.f; bf16x8 pa0, pa1, pa2, pa3;
  constexpr int NT = MODE == 0 ? SEQ / 64 : 4;
  if (MODE == 1) {
    const float lb2 = -nlb2;
    {
      const int sr4 = tid >> 4, sc4 = (tid & 15) * 8;
#pragma unroll
      for (int dir = 0; dir < 2; ++dir) {
        float accs[4][8];
#pragma unroll
        for (int q = 0; q < 4; ++q)
#pragma unroll
          for (int e = 0; e < 8; ++e) accs[q][e] = 0.f;
#pragma unroll
        for (int mb = 0; mb < 8; mb += 4) {
          const bool any = dir == 0 ? (mb < nblk) : (mb + 3 > nblk);
          if (any) {
            u32x4 x[4][4];
#pragma unroll
            for (int mi = 0; mi < 4; ++mi) {
              const u16* Pm = Pst + (size_t)((mb + mi) * 2 + dir) * 16384 + sc4;
#pragma unroll
              for (int q = 0; q < 4; ++q) x[mi][q] = *reinterpret_cast<const u32x4*>(Pm + (sr4 + 32 * q) * 128);
            }
#pragma unroll
            for (int mi = 0; mi < 4; ++mi) {
              const int m = mb + mi;
              const bool in = dir == 0 ? (m < nblk) : (m > nblk);
              const float wgt = in ? __builtin_amdgcn_exp2f((dir == 0 ? lf2 * (float)(nblk - 1 - m) : lb2 * (float)(m - nblk - 1)) * 256.f) : 0.f;
#pragma unroll
              for (int q = 0; q < 4; ++q)
#pragma unroll
                for (int e = 0; e < 4; ++e) { accs[q][2 * e] = fmaf(wgt, bflo(x[mi][q][e]), accs[q][2 * e]); accs[q][2 * e + 1] = fmaf(wgt, bfhi(x[mi][q][e]), accs[q][2 * e + 1]); }
            }
          }
        }
#pragma unroll
        for (int q = 0; q < 4; ++q) {
          const int row = sr4 + 32 * q;
          u32x4 w; w[0] = cvtpk(accs[q][0], accs[q][1]); w[1] = cvtpk(accs[q][2], accs[q][3]); w[2] = cvtpk(accs[q][4], accs[q][5]); w[3] = cvtpk(accs[q][6], accs[q][7]);
          *reinterpret_cast<u32x4*>(lds + dir * 32768 + (row >> 6) * 16384 + v_st(row & 63, sc4)) = w;
        }
      }
    }
    __syncthreads();
    const float rowpos = (float)(wid * 32 + r32);
#pragma unroll
    for (int dir = 0; dir < 2; ++dir) {
      const float rf = __builtin_amdgcn_exp2f(dir == 0 ? lf2 * rowpos : lb2 * (256.f - rowpos));
      bf16x8 qs[8];
#pragma unroll
      for (int k = 0; k < 8; ++k) {
        u32x4 w;
#pragma unroll
        for (int e = 0; e < 4; ++e) w[e] = cvtpk(bf2f((u16)qr[k][2 * e]) * rf, bf2f((u16)qr[k][2 * e + 1]) * rf);
        qs[k] = *reinterpret_cast<bf16x8*>(&w);
      }
      const int vbs = (int)(uintptr_t)(lds + dir * 32768) + v_rd_base(lane);
      pv_d0(o, vbs, qs[0], qs[1], qs[2], qs[3]);
      pv_d0(o, vbs + 16384, qs[4], qs[5], qs[6], qs[7]);
    }
    __syncthreads();
  }
  SLOAD(0); SWRITE(0); __syncthreads();
  qkt<DQK>(pA0, pA1, K_lds, qr, qsave, r32, hi); PART(pA0, pA1, mnA, alA, 0);
  SLOAD(64); SWRITE(1); __syncthreads();
  for (int j = 1; j + 1 < NT; j += 2) {
    SBAR(); qkt<DQK>(pB0, pB1, K_lds + SHM_K, qr, qsave, r32, hi);
    FIN(pA0, pA1, alA); SBAR();
    SLOAD((j + 1) * 64); SBAR();
    pv_d0(o, vb0, pa0, pa1, pa2, pa3); PART(pB0, pB1, mnB, alB, j * 64);
    __syncthreads(); SWRITE(0);
    RESC(alB); __syncthreads();
    SBAR(); qkt<DQK>(pA0, pA1, K_lds, qr, qsave, r32, hi);
    FIN(pB0, pB1, alB); SBAR();
    SLOAD((j + 2) * 64); SBAR();
    pv_d0(o, vb0 + SHM_V, pa0, pa1, pa2, pa3); PART(pA0, pA1, mnA, alA, (j + 1) * 64);
    __syncthreads(); SWRITE(1);
    RESC(alA); __syncthreads();
  }
  SBAR(); qkt<DQK>(pB0, pB1, K_lds + SHM_K, qr, qsave, r32, hi);
  FIN(pA0, pA1, alA); SBAR();
  pv_d0(o, vb0, pa0, pa1, pa2, pa3); PART(pB0, pB1, mnB, alB, (NT - 1) * 64);
  __syncthreads(); RESC(alB);
  FIN(pB0, pB1, alB); SBAR();
  pv_d0(o, vb0 + SHM_V, pa0, pa1, pa2, pa3);
  u16* Yw = Yp + (size_t)(wid * 32) * 2048;
  if (MODE == 0) {
    if (hi == 0) li_l[r32] = l_reg;
    asm volatile("s_waitcnt lgkmcnt(0)" ::: "memory");
#pragma unroll
    for (int r = 0; r < 16; ++r) {
      const float rli = __builtin_amdgcn_rcpf(li_l[crow(r, hi)]);
#pragma unroll
      for (int d = 0; d < 4; ++d) o[d][r] *= rli;
    }
  } else {
#pragma unroll
    for (int r = 0; r < 16; ++r) {
      float s = o[0][r] + o[1][r] + o[2][r] + o[3][r];
#pragma unroll
      for (int m = 16; m >= 1; m >>= 1) s += __shfl_xor(s, m);
      const float mu = s * (1.f / 128.f);
      float dv = 0.f;
#pragma unroll
      for (int d = 0; d < 4; ++d) { const float t = o[d][r] - mu; dv += t * t; }
#pragma unroll
      for (int m = 16; m >= 1; m >>= 1) dv += __shfl_xor(dv, m);
      const float rstd = rsqrtf(dv * (1.f / 128.f) + EPS);
#pragma unroll
      for (int d = 0; d < 4; ++d) o[d][r] = (o[d][r] - mu) * rstd;
    }
  }
  __syncthreads();
  {
    float* ot = reinterpret_cast<float*>(lds + wid * 16384);
#pragma unroll
    for (int r = 0; r < 16; ++r) {
      const int orow = crow(r, hi);
#pragma unroll
      for (int d = 0; d < 4; ++d) ot[orow * 128 + ((d * 32 + r32 + 4 * orow) & 127)] = o[d][r];
    }
    asm volatile("s_waitcnt lgkmcnt(0)" ::: "memory");
    const int erow = lane >> 1, ecol = (lane & 1) * 64;
    u16* yp = Yw + (size_t)erow * 2048 + ecol;
    u32x4 gt[8];
#pragma unroll
    for (int i = 0; i < 8; ++i) gt[i] = *reinterpret_cast<const u32x4*>(yp + 8 * i);
#pragma unroll
    for (int i = 0; i < 8; ++i) {
      const f32x4 a = *reinterpret_cast<const f32x4*>(ot + erow * 128 + ((ecol + 8 * i + 4 * erow) & 127));
      const f32x4 b = *reinterpret_cast<const f32x4*>(ot + erow * 128 + ((ecol + 8 * i + 4 + 4 * erow) & 127));
      u32x4 w;
      w[0] = cvtpk(a[0] * bflo(gt[i][0]), a[1] * bfhi(gt[i][0])); w[1] = cvtpk(a[2] * bflo(gt[i][1]), a[3] * bfhi(gt[i][1]));
      w[2] = cvtpk(b[0] * bflo(gt[i][2]), b[1] * bfhi(gt[i][2])); w[3] = cvtpk(b[2] * bflo(gt[i][3]), b[3] * bfhi(gt[i][3]));
      if (dowrite) *reinterpret_cast<u32x4*>(yp + 8 * i) = w;
    }
  }
  __syncthreads();
#undef SLOAD
#undef SWRITE
#undef RESC
#undef PART
#undef FIN
}

__device__ void ret_pbuild(const u16* __restrict__ U, u16* __restrict__ Pout, const float* __restrict__ cosr, const float* __restrict__ sinr, int tok0, int hh, int m, int dir, float lg2v, char* lds) {
  const int tid = TID(), wid = tid >> 6, lane = tid & 63, r32 = lane & 31, hi = lane >> 5;
  char* Ks = lds; char* Vs = lds + 16384;
  const int a = wid >> 1, b0 = (wid & 1) * 2;
  const int kb = (int)(uintptr_t)Ks + v_rd_base(lane) + a * 512;
  const int vb = (int)(uintptr_t)Vs + v_rd_base(lane) + b0 * 512;
  f32x16 acc0, acc1;
#pragma unroll
  for (int r = 0; r < 16; ++r) { acc0[r] = 0.f; acc1[r] = 0.f; }
  const float g64 = __builtin_amdgcn_exp2f(lg2v * 64.f);
  const int krow = tid >> 3, kc = (tid & 7) * 8;
  const int sr = tid >> 4, sc = (tid & 15) * 8;
  const float pre = 0.08838834764831845f * __builtin_amdgcn_exp2f(dir == 0 ? -lg2v * (float)krow : lg2v * (float)krow);
  for (int tt = 0; tt < 4; ++tt) {
    const int t = dir == 0 ? tt : 3 - tt;
    const int key0 = m * 256 + t * 64;
    const u16* kp = U + (size_t)(tok0 + key0 + krow) * NU + 1536 + hh * 128 + kc;
    const u32x4 x1 = *reinterpret_cast<const u32x4*>(kp), x2 = *reinterpret_cast<const u32x4*>(kp + 64);
    const u16* vp = U + (size_t)(tok0 + key0 + sr) * NU + 2048 + hh * 128 + sc;
    const bf16x8 v0 = *reinterpret_cast<const bf16x8*>(vp), v1 = *reinterpret_cast<const bf16x8*>(vp + (size_t)32 * NU);
    const float* cp = cosr + (key0 + krow) * 64 + kc; const float* sp = sinr + (key0 + krow) * 64 + kc;
    const f32x4 c0 = *reinterpret_cast<const f32x4*>(cp), c1 = *reinterpret_cast<const f32x4*>(cp + 4);
    const f32x4 s0 = *reinterpret_cast<const f32x4*>(sp), s1 = *reinterpret_cast<const f32x4*>(sp + 4);
    u32x4 w1, w2;
#pragma unroll
    for (int e = 0; e < 4; ++e) {
      const float ca = e < 2 ? c0[2 * e] : c1[2 * e - 4], cb = e < 2 ? c0[2 * e + 1] : c1[2 * e - 3];
      const float sa = e < 2 ? s0[2 * e] : s1[2 * e - 4], sb = e < 2 ? s0[2 * e + 1] : s1[2 * e - 3];
      const float xa = bflo(x1[e]), xb = bfhi(x1[e]), ya = bflo(x2[e]), yb = bfhi(x2[e]);
      w1[e] = cvtpk((xa * ca - ya * sa) * pre, (xb * cb - yb * sb) * pre);
      w2[e] = cvtpk((ya * ca + xa * sa) * pre, (yb * cb + xb * sb) * pre);
    }
    *reinterpret_cast<u32x4*>(Ks + v_st(krow, kc)) = w1; *reinterpret_cast<u32x4*>(Ks + v_st(krow, 64 + kc)) = w2;
    *reinterpret_cast<bf16x8*>(Vs + v_st(sr, sc)) = v0; *reinterpret_cast<bf16x8*>(Vs + v_st(32 + sr, sc)) = v1;
    __syncthreads();
    if (tt > 0) {
#pragma unroll
      for (int r = 0; r < 16; ++r) { acc0[r] *= g64; acc1[r] *= g64; }
    }
#define PK(L, H) (bf16x8){L[0], L[1], L[2], L[3], H[0], H[1], H[2], H[3]}
#define PB_STEP(KS) do { \
      const s16x4 al = tr_read<v_rd_off(0, KS, 0)>(kb), ah = tr_read<v_rd_off(0, KS, 1)>(kb); \
      const s16x4 bl0 = tr_read<v_rd_off(0, KS, 0)>(vb), bh0 = tr_read<v_rd_off(0, KS, 1)>(vb); \
      const s16x4 bl1 = tr_read<v_rd_off(1, KS, 0)>(vb), bh1 = tr_read<v_rd_off(1, KS, 1)>(vb); \
      asm volatile("s_waitcnt lgkmcnt(0)" ::: "memory"); SBAR(); \
      acc0 = __builtin_amdgcn_mfma_f32_32x32x16_bf16(PK(al, ah), PK(bl0, bh0), acc0, 0, 0, 0); \
      acc1 = __builtin_amdgcn_mfma_f32_32x32x16_bf16(PK(al, ah), PK(bl1, bh1), acc1, 0, 0, 0); } while (0)
    PB_STEP(0); PB_STEP(1); PB_STEP(2); PB_STEP(3);
#undef PB_STEP
#undef PK
    __syncthreads();
  }
  if (dir == 0) {
#pragma unroll
    for (int r = 0; r < 16; ++r) { acc0[r] *= g64; acc1[r] *= g64; }
  }
#pragma unroll
  for (int r = 0; r < 16; ++r) {
    u16* pp = Pout + (size_t)(32 * a + crow(r, hi)) * 128 + 32 * b0 + r32;
    pp[0] = f2bf(acc0[r]); pp[32] = f2bf(acc1[r]);
  }
}

#define XB_TMO      128
#define XB_XCNT(j)  (256  + 64 * (j))
#define XB_XSUB(j)  (1280 + 64 * (j))
#define XB_XGEN(j)  (2304 + 64 * (j))
#define XB_TOP      3328
#define XB_TOPGEN   3392
#define XCD_BAR_WORDS 3456
#define XB_SPIN_CAP (1u << 18)
__device__ __forceinline__ unsigned xb_ld(unsigned* p)              { return __hip_atomic_load(p, __ATOMIC_RELAXED, __HIP_MEMORY_SCOPE_AGENT); }
__device__ __forceinline__ unsigned xb_add(unsigned* p, unsigned v) { return __hip_atomic_fetch_add(p, v, __ATOMIC_RELAXED, __HIP_MEMORY_SCOPE_AGENT); }
__device__ __forceinline__ unsigned xb_xcc_id() { return (unsigned)__builtin_amdgcn_s_getreg((3 << 11) | 20) & 0xFu; }
#define XB_SPIN(cond, bar) do { unsigned _sp = 0; while (cond) { __builtin_amdgcn_s_sleep(1); \
    if ((++_sp & 255u) == 0u) { if (xb_ld(&(bar)[XB_TMO])) break; if (_sp > XB_SPIN_CAP) { atomicAdd(&(bar)[XB_TMO], 1u); break; } } } } while (0)
struct XcdBarrier { unsigned* bar; unsigned x; volatile LAS unsigned* st; };
__device__ __forceinline__ XcdBarrier xcd_barrier_post(unsigned* bar, volatile LAS unsigned* st) {
  XcdBarrier b; b.bar = bar; b.x = xb_xcc_id(); b.st = st;
  if (threadIdx.x == 0) (void)xb_add(&bar[XB_XCNT(b.x)], 1u);
  return b;
}
__device__ __forceinline__ void xcd_barrier_complete(unsigned* bar, unsigned x, unsigned& nloc, unsigned& nx) {
  const unsigned G = gridDim.x * gridDim.y * gridDim.z;
  unsigned sum, cnt, mine, sp = 0u;
  for (;;) {
    sum = 0u; cnt = 0u; mine = 0u;
#pragma unroll
    for (unsigned j = 0; j < 16; ++j) { const unsigned c = xb_ld(&bar[XB_XCNT(j)]); sum += c; cnt += (c > 0u) ? 1u : 0u; mine = (j == x) ? c : mine; }
    if (sum == G) break;
    __builtin_amdgcn_s_sleep(1);
    if ((++sp & 255u) == 0u) { if (xb_ld(&bar[XB_TMO])) break; if (sp > XB_SPIN_CAP) { atomicAdd(&bar[XB_TMO], 1u); break; } }
  }
  nloc = mine > 0u ? mine : 1u; nx = cnt > 0u ? cnt : 1u;
}
__device__ __forceinline__ void xcd_barrier(const XcdBarrier& b) {
  asm volatile("s_waitcnt vmcnt(0)" ::: "memory");
  __syncthreads();
  if (threadIdx.x == 0) {
    unsigned* bar = b.bar;
    __builtin_amdgcn_s_waitcnt(0);
    unsigned nloc = b.st[0], nx = b.st[1];
    if (nloc == 0u) { xcd_barrier_complete(bar, b.x, nloc, nx); b.st[0] = nloc; b.st[1] = nx; }
    const unsigned old = xb_add(&bar[XB_XSUB(b.x)], 1u);
    const unsigned gen = old / nloc;
    if (old + 1u == (gen + 1u) * nloc) {
      __builtin_amdgcn_fence(__ATOMIC_RELEASE, "agent");
      asm volatile("s_waitcnt vmcnt(0)" ::: "memory");
      const unsigned og = xb_add(&bar[XB_TOP], 1u);
      const unsigned tg = og / nx;
      if (og + 1u == (tg + 1u) * nx) xb_add(&bar[XB_TOPGEN], 1u);
      else XB_SPIN(xb_ld(&bar[XB_TOPGEN]) == tg, bar);
      __builtin_amdgcn_fence(__ATOMIC_ACQUIRE, "agent");
      xb_add(&bar[XB_XGEN(b.x)], 1u);
      asm volatile("s_waitcnt vmcnt(0)" ::: "memory");
    } else {
      XB_SPIN(xb_ld(&bar[XB_XGEN(b.x)]) == gen, bar);
      __builtin_amdgcn_fence(__ATOMIC_ACQUIRE, "agent");
      asm volatile("s_waitcnt vmcnt(0)" ::: "memory");
    }
  }
  __syncthreads();
}

constexpr int N_PHASES = 22;

__device__ void run_phase(const Params& p, int ph, char* lds, const XcdBarrier& xb) {
  char* ws = p.ws;
  u16* XN = (u16*)(ws + OFF_XN); u16* U = (u16*)(ws + OFF_U); u16* Y = (u16*)(ws + OFF_Y); u16* Q = (u16*)(ws + OFF_Q); u16* KV = (u16*)(ws + OFF_KV);
  const float* cosr = (const float*)(ws + OFF_COSR); const float* sinr = (const float*)(ws + OFF_SINR);
  const float* cosm = (const float*)(ws + OFF_COSM); const float* sinm = (const float*)(ws + OFF_SINM);
  if (ph == N_PHASES - 1) { phase_final(p.out, p.in[13]); return; }
  const int bid_ = BID(); const int xcd = bid_ & 7, slot = bid_ >> 3, nslots = gridDim.x >> 3;
  const int lh = (ph - 1) / 5, sub = (ph - 1) % 5, l = lh >> 1, h = lh & 1;
  const size_t xoff = (size_t)h * MH * DM;
  const float* xin = (l == 0 ? p.in[0] : (const float*)p.out) + xoff;
  u16* Yh = Y + (size_t)h * MH * 2048;
  float* SSQ = (float*)(ws + OFF_SSQ);
  const bool fuse_ok = MK_COOP && nslots == 32;
  const u16* XNh = XN + (size_t)h * MH * DM;
  if (sub == 0) {
    if (h == 0) { for (int i = bid_ * NTHR + TID(); i < 6 * MH; i += gridDim.x * NTHR) SSQ[i] = 0.f; }
    if (lh != 0 && h == 0) { for (int rep = 0; rep < REP_NORM; ++rep) phase_norm(xin, XN, bid_, gridDim.x); }
  } else if (sub == 1) {
    if (fuse_ok && l == 1 && h == 0) { for (int i = bid_ * NTHR + TID(); i < 2 * MH; i += gridDim.x * NTHR) SSQ[4 * MH + i] = 0.f; }
    EpiArgs ea{}; ea.c0 = U; ea.c1 = Yh; ea.ssq_q = SSQ + (size_t)h * 2 * MH; ea.ssq_kv = SSQ + (size_t)h * 2 * MH + MH;
    const u16* Bt = (const u16*)(ws + OFF_WIN) + (size_t)l * NINP * 1024;
    for (int rep = 0; rep < REP_B; ++rep)
      gemm256_tiles<EPI2_IN, true>(XNh, 1024, Bt, 1024, slot, 4 * 16, nslots, xcd, 2, lds, ea);
  } else if (sub == 2) {
    for (int rep = 0; rep < REP_ROPE; ++rep)
    rope_rows(U, (u16*)(ws + OFF_K3), (const float*)(ws + OFF_LG2) + l * 8, cosr, sinr, cosm, sinm, rep == REP_ROPE - 1);
    {
      EpiArgs ea{}; ea.c0 = U; ea.c1 = Yh; ea.ssq_q = SSQ + (size_t)h * 2 * MH; ea.ssq_kv = SSQ + (size_t)h * 2 * MH + MH;
      const u16* Bt = (const u16*)(ws + OFF_WIN) + (size_t)l * NINP * 1024;
      gemm256_tiles<EPI2_IN, true>(XNh, 1024, Bt, 1024, 64 + slot, 4 * 21, nslots, xcd, 2, lds, ea);
    }
    for (int rep = 0; rep < REP_PB; ++rep)
    for (int tk = slot; tk < 32; tk += nslots) {
      const int pr = xcd * 2 + (tk >> 4), m = (tk >> 1) & 7, dir = tk & 1;
      const float lg = ((const float*)(ws + OFF_LG2))[l * 8 + dir * 4 + (pr & 3)];
      ret_pbuild(U, (u16*)(ws + OFF_PST) + (size_t)((pr * 8 + m) * 2 + dir) * 16384, cosr, sinr, (pr >> 2) * SEQ, pr & 3, m, dir, lg, lds);
    }
    {
      EpiArgs ea{}; ea.c0 = Q; ea.ssq_q = SSQ + (size_t)h * 2 * MH;
      const u16* Bt = (const u16*)(ws + OFF_WUQ) + (size_t)l * 1536 * 384;
      for (int rep = 0; rep < REP_UP; ++rep)
        if (nslots == 32) { if (slot >= 20) gemm256_tiles<EPI2_Q>(U + 2560, NU, Bt, 384, slot - 20, 4 * 6, 12, xcd, 2, lds, ea); }
        else gemm256_tiles<EPI2_Q>(U + 2560, NU, Bt, 384, slot, 4 * 6, nslots, xcd, 2, lds, ea);
    }
    {
      EpiArgs ea{}; ea.c0 = KV; ea.ssq_kv = SSQ + (size_t)h * 2 * MH + MH;
      const u16* Bt = (const u16*)(ws + OFF_WUKV) + (size_t)l * 2048 * 256;
      for (int rep = 0; rep < REP_UP; ++rep)
        gemm256_tiles<EPI2_KV>(U + 2944, NU, Bt, 256, slot, 4 * 8, nslots, xcd, 2, lds, ea);
    }
  } else if (sub == 3) {
    for (int j = slot; j < 32 + 16; j += nslots) {
      if (j < 32) {
        const int it = (xcd * 4 + (j >> 3)) * 8 + (j & 7);
        const int qb = it & 7, hh = (it >> 3) & 7, b = it >> 6;
        const size_t tok0 = (size_t)b * SEQ, i0 = tok0 + qb * 256;
        for (int rep = 0; rep < REP_MLA; ++rep)
        attn_item<0>(Q + i0 * 1536 + hh * 192, 1536, KV + tok0 * 2048 + hh * 256, 2048, U + tok0 * NU + 3200,
                     KV + tok0 * 2048 + hh * 256 + 128, 2048, Yh + i0 * 2048 + 1024 + hh * 128, qb * 256, 0.f, 0.f, lds, rep == REP_MLA - 1, cosm, sinm);
      } else {
        const int r = (xcd * 2 + ((j - 32) >> 3)) * 8 + (j & 7);
        const int qb = r & 7, hh = (r >> 3) & 3, b = r >> 5;
        const size_t tok0 = (size_t)b * SEQ, i0 = tok0 + qb * 256;
        const float* dl = (const float*)(ws + OFF_LG2) + l * 8;
        const float lf2 = dl[hh], lb2 = dl[4 + hh];
        for (int rep = 0; rep < REP_RET; ++rep)
        attn_item<1>(U + i0 * NU + 1024 + hh * 128, NU, (const u16*)(ws + OFF_K3) + i0 * 512 + hh * 128, 512, nullptr,
                     U + i0 * NU + 2048 + hh * 128, NU, Yh + i0 * 2048 + 512 + hh * 128, qb * 256, lf2, -lb2, lds, rep == REP_RET - 1, nullptr, nullptr,
                     (const u16*)(ws + OFF_PST) + (size_t)(r >> 3) * 8 * 2 * 16384, qb);
      }
    }
    {
      const bool split = (nslots == 32);
      const int ib = split ? xcd * 16 + (slot - 16) : bid_, nib = split ? 128 : (int)gridDim.x;
      if (!split || slot >= 16) {
        for (int rep = 0; rep < REP_CONV; ++rep)
        for (int t = ib; t < MH / 32; t += nib)
          conv_tile(U, Yh, p.in[3] + (size_t)l * 31 * 512, p.in[4] + l * 512, p.in[5] + l * 512, p.in[6] + l * 512, t * 32, lds, rep == REP_CONV - 1);
        if (h == 0 && !(fuse_ok && l == 1)) {
          const float* xnext = (l == 0 ? p.in[0] : (const float*)p.out) + (size_t)MH * DM;
          for (int rep = 0; rep < REP_NORM; ++rep) phase_norm(xnext, XN + (size_t)MH * DM, ib, nib, 0, split ? 5376 : MH);
        }
      }
      if (split && slot < 16 && h == 0 && !(fuse_ok && l == 1)) {
        const float* xnext = (l == 0 ? p.in[0] : (const float*)p.out) + (size_t)MH * DM;
        for (int rep = 0; rep < REP_NORM; ++rep) phase_norm(xnext, XN + (size_t)MH * DM, xcd * 16 + slot, 128, 5376, MH);
      }
    }
  } else {
    if (h == 1) {
      EpiArgs ea{}; ea.resid = (l == 0 ? p.in[0] : (const float*)p.out); ea.xout = p.out;
      ea.fuse = fuse_ok ? 1 : 0; ea.xb = &xb; ea.ssqf = (float*)(ws + OFF_SSQF); ea.fg = p.in[13]; ea.xn_out = (l == 0 ? XN : nullptr);
      if (fuse_ok && l == 0) { for (int i = bid_ * NTHR + TID(); i < 4 * MH; i += gridDim.x * NTHR) SSQ[i] = 0.f; }
      const u16* Bt = (const u16*)(ws + OFF_WOUT) + (size_t)l * 1024 * 2048;
      for (int rep = 0; rep < (l == 0 ? REP_E0 : 1); ++rep)
        if (ea.fuse) gemm256_tiles<EPI2_OUTF>(Y, 2048, Bt, 2048, slot, 8 * 4, nslots, xcd, 3, lds, ea);
        else gemm256_tiles<EPI2_OUT>(Y, 2048, Bt, 2048, slot, 8 * 4, nslots, xcd, 3, lds, ea);
    }
  }
}
__device__ __forceinline__ bool phase_empty(int ph) {
  if (ph == 1) return true;
  if (MK_COOP && (gridDim.x >> 3) == 32 && ph == 11) return true;
  if (ph >= 1 && ph < N_PHASES - 1) { const int lh = (ph - 1) / 5, sub = (ph - 1) % 5; if (sub == 4 && (lh & 1) == 0) return true; if (sub == 0 && (lh & 1) == 1) return true; }
  return false;
}

__global__ void __launch_bounds__(NTHR) mega_kernel(Params p, int ph_lo, int ph_hi) {
  extern __shared__ __attribute__((aligned(16))) char lds[];
  __shared__ uint4 xb_words;
  if (threadIdx.x == 0) xb_words = make_uint4(0u, 0u, 0u, 0u);
  __syncthreads();
  XcdBarrier xb = xcd_barrier_post((unsigned*)(p.ws + OFF_BAR), (volatile LAS unsigned*)&xb_words);
  int ph = ph_lo;
  if (ph == 0) {
    for (int rep = 0; rep < REP_PREP; ++rep) phase_prep(p, lds);
    for (int rep = 0; rep < REP_NORM; ++rep) phase_norm(p.in[0], (u16*)(p.ws + OFF_XN), BID(), gridDim.x);
    for (int i = BID() * NTHR + TID(); i < 6 * MH; i += gridDim.x * NTHR) ((float*)(p.ws + OFF_SSQ))[i] = 0.f;
    ph = 1;
    if (ph_hi > 1000000) cg::this_grid().sync();
    if (ph < ph_hi) xcd_barrier(xb);
  }
  const int ph_end = (MK_COOP && (gridDim.x >> 3) == 32 && ph_hi == N_PHASES) ? N_PHASES - 1 : ph_hi;
  for (; ph < ph_end; ++ph) {
    if (phase_empty(ph)) continue;
    run_phase(p, ph, lds, xb);
    if (ph + 1 < ph_end) { for (int rep = 0; rep < REP_SYNC; ++rep) xcd_barrier(xb); }
  }
}

extern "C" void kernel_launch(void* const* d_in, const int* in_sizes, int n_in, void* d_out, int out_size, void* d_ws, size_t ws_size, hipStream_t stream) {
  static int grid = 0;
  if (grid == 0) {
    if (n_in != 14 || ws_size < WS_END) { fprintf(stderr, "kernel_launch: bad setup n_in %d ws %zu need %zu\n", n_in, ws_size, (size_t)WS_END); return; }
    int dev = 0, cus = 0, per_cu = 0;
    hipGetDevice(&dev);
    hipDeviceGetAttribute(&cus, hipDeviceAttributeMultiprocessorCount, dev);
    if (hipFuncSetAttribute((const void*)mega_kernel, hipFuncAttributeMaxDynamicSharedMemorySize, LDS_BYTES) != hipSuccess) { fprintf(stderr, "hipFuncSetAttribute failed\n"); return; }
    hipOccupancyMaxActiveBlocksPerMultiprocessor(&per_cu, (const void*)mega_kernel, NTHR, LDS_BYTES);
    if (per_cu < 1) { fprintf(stderr, "occupancy query says %d\n", per_cu); (void)hipGetLastError(); per_cu = 1; }
    grid = (cus / 8) * 8;
  }
  Params p{};
  for (int i = 0; i < 14; ++i) p.in[i] = (const float*)d_in[i];
  p.out = (float*)d_out; p.ws = (char*)d_ws;
#if MK_COOP
  hipMemsetAsync((char*)d_ws + OFF_BAR, 0, XCD_BAR_WORDS * 4, stream);
  int lo = 0, hi = N_PHASES;
  void* args[] = {&p, &lo, &hi};
  hipError_t e = hipLaunchCooperativeKernel((const void*)mega_kernel, dim3(grid), dim3(NTHR), args, LDS_BYTES, stream);
  if (e != hipSuccess) fprintf(stderr, "cooperative launch failed: %s (grid %d)\n", hipGetErrorString(e), grid);
#else
  for (int ph = 0; ph < N_PHASES; ++ph) {
    if (ph == 1 || ph == 5 || ph == 15 || ph == 6 || ph == 16) continue;
    hipLaunchKernelGGL(mega_kernel, dim3(grid), dim3(NTHR), LDS_BYTES, stream, p, ph, ph + 1);
  }
#endif
}
```
